# Optimizing an MI355X kernel written in HIP

```python
import jax, jax.numpy as jnp
from jax import lax
import numpy as np

D_MODEL = 1024
BATCH = 16
SEQ = 2048
DEPTH = 1

RWKV_HEADS = 8
RWKV_HEAD_DIM = 64
RWKV_DIM = RWKV_HEADS * RWKV_HEAD_DIM
DECAY_LORA = 64
AAA_LORA = 64
GATE_LORA = 128
GN_EPS = 64e-5
RWKV_COLS = 3 * RWKV_DIM + DECAY_LORA + AAA_LORA + GATE_LORA
RWKV_SPLITS = (RWKV_DIM, 2 * RWKV_DIM, 3 * RWKV_DIM, 3 * RWKV_DIM + DECAY_LORA,
               3 * RWKV_DIM + DECAY_LORA + AAA_LORA)

ATTN_HEADS = 8
ATTN_KV_HEADS = 2
ATTN_HEAD_DIM = 64
ATTN_GROUP = ATTN_HEADS // ATTN_KV_HEADS
ATTN_DIM = ATTN_HEADS * ATTN_HEAD_DIM
KV_DIM = ATTN_KV_HEADS * ATTN_HEAD_DIM
ATTN_COLS = ATTN_DIM + 2 * KV_DIM
ATTN_SPLITS = (ATTN_DIM, ATTN_DIM + KV_DIM)
WINDOW = 128
BLOCK = 128

IN_COLS = RWKV_COLS + ATTN_COLS + 2 * D_MODEL
IN_SPLITS = (RWKV_COLS, RWKV_COLS + ATTN_COLS, RWKV_COLS + ATTN_COLS + D_MODEL)

D_FF = 2816
CONV_WIDTH = 3
RMS_EPS = 1e-6

kernel_name = "hybrid_rwkv7_swa_sink_alibi_convffn_adaln"


def rms_norm(x, gain):
    xf = x.astype(jnp.float32)
    y = xf * lax.rsqrt(jnp.mean(xf * xf, axis=-1, keepdims=True) + RMS_EPS)
    return (y * gain.astype(jnp.float32)).astype(x.dtype)


def token_shift(t):
    return jnp.pad(t, ((0, 0), (1, 0), (0, 0)))[:, :-1]


def rwkv7_scan(r, decay, k, v, a, b):
    bsz, _, heads, n = r.shape

    def step(state, inp):
        r_t, w_t, k_t, v_t, a_t, b_t = inp
        sa = jnp.einsum('bhvk,bhk->bhv', state, a_t)
        state = (state * w_t[:, :, None, :] + sa[..., None] * b_t[:, :, None, :]
                 + v_t[..., None] * k_t[:, :, None, :])
        y = jnp.einsum('bhvk,bhk->bhv', state, r_t)
        return state, y

    xs = tuple(jnp.swapaxes(t, 0, 1).astype(jnp.float32) for t in (r, decay, k, v, a, b))
    s0 = jnp.zeros((bsz, heads, n, n), jnp.float32)
    _, ys = lax.scan(step, s0, xs)
    return jnp.swapaxes(ys, 0, 1).astype(r.dtype)


def rwkv7_branch(feat, mu, w0, w_up, a0, a_up, g_up, k_k, k_a, r_k, gn_w, gn_b):
    bsz, seq, _ = feat.shape
    hs = (bsz, seq, RWKV_HEADS, RWKV_HEAD_DIM)
    f = feat + (token_shift(feat) - feat) * mu
    r, k, v, w_lo, a_lo, g_lo = jnp.split(f, RWKV_SPLITS, axis=-1)
    w = -jax.nn.softplus(-(w0 + jnp.tanh(w_lo) @ w_up)) - 0.5
    decay = jnp.exp(-jnp.exp(w.astype(jnp.float32)))
    a = jax.nn.sigmoid(a0 + a_lo @ a_up)
    g = jax.nn.sigmoid(g_lo) @ g_up
    kk = (k * k_k).reshape(hs).astype(jnp.float32)
    kk = (kk / jnp.maximum(jnp.sqrt(jnp.sum(kk * kk, -1, keepdims=True)), 1e-12)).astype(k.dtype)
    k = k * (1.0 + (a - 1.0) * k_a)
    a_h = a.reshape(hs)
    r_h, k_h, v_h = r.reshape(hs), k.reshape(hs), v.reshape(hs)
    y = rwkv7_scan(r_h, decay.reshape(hs), k_h, v_h, -kk, kk * a_h)
    yf = y.astype(jnp.float32)
    mean = jnp.mean(yf, -1, keepdims=True)
    var = jnp.mean(jnp.square(yf - mean), -1, keepdims=True)
    y = ((yf - mean) * lax.rsqrt(var + GN_EPS)).astype(feat.dtype)
    y = y * gn_w.reshape(RWKV_HEADS, RWKV_HEAD_DIM) + gn_b.reshape(RWKV_HEADS, RWKV_HEAD_DIM)
    y = y + jnp.sum(r_h * k_h * r_k, -1, keepdims=True) * v_h
    return y.reshape(bsz, seq, RWKV_DIM) * g


def swa_sink_attention(q, k, v, sinks):
    bsz, seq = q.shape[:2]
    nblk = seq // BLOCK
    qb = q.reshape(bsz, nblk, BLOCK, ATTN_KV_HEADS, ATTN_GROUP, ATTN_HEAD_DIM).transpose(1, 0, 2, 3, 4, 5)

    def band(t):
        tp = jnp.pad(t, ((0, 0), (BLOCK, 0), (0, 0), (0, 0)))
        tp = tp.reshape(bsz, nblk + 1, BLOCK, ATTN_KV_HEADS, ATTN_HEAD_DIM)
        return jnp.concatenate([tp[:, :-1], tp[:, 1:]], axis=2).transpose(1, 0, 2, 3, 4)

    kb, vb = band(k), band(v)
    qi = jnp.arange(BLOCK)[:, None]
    sj = jnp.arange(2 * BLOCK)[None, :]
    dist = qi + BLOCK - sj
    in_window = (dist >= 0) & (dist < WINDOW)
    slopes = 2.0 ** (-8.0 * jnp.arange(1, ATTN_HEADS + 1, dtype=jnp.float32) / ATTN_HEADS)
    alibi = -slopes.reshape(ATTN_KV_HEADS, ATTN_GROUP)[:, :, None, None] * dist.astype(jnp.float32)
    sink = sinks.astype(jnp.float32).reshape(ATTN_KV_HEADS, ATTN_GROUP)[None, :, :, None, None]
    scale = ATTN_HEAD_DIM ** -0.5

    def one_block(args):
        blk, q_blk, k_blk, v_blk = args
        s = jnp.einsum('bqkgd,bskd->bkgqs', q_blk, k_blk).astype(jnp.float32) * scale + alibi
        valid = in_window & (blk * BLOCK + sj - BLOCK >= 0)
        s = jnp.where(valid, s, -jnp.inf)
        m = jnp.maximum(jnp.max(s, -1, keepdims=True), sink)
        p = jnp.exp(s - m)
        p = p / (jnp.sum(p, -1, keepdims=True) + jnp.exp(sink - m))
        return jnp.einsum('bkgqs,bskd->bqkgd', p.astype(v_blk.dtype), v_blk)

    out = lax.map(one_block, (jnp.arange(nblk), qb, kb, vb))
    return out.transpose(1, 0, 2, 3, 4, 5).reshape(bsz, seq, ATTN_DIM)


def conv_gated_ffn(u, w_up, conv_w, conv_b, w_down):
    gate, val = jnp.split(u @ w_up, 2, axis=-1)
    gate = lax.conv_general_dilated(gate, conv_w[:, None, :], window_strides=(1,),
                                    padding=[(CONV_WIDTH - 1, 0)],
                                    dimension_numbers=('NWC', 'WIO', 'NWC'),
                                    feature_group_count=D_FF) + conv_b
    return (jax.nn.silu(gate) * val) @ w_down


def setup_inputs(seed: int = 0) -> dict:
    key = jax.random.key(seed)
    ks = jax.random.split(key, 32)
    f32 = jnp.float32
    L = DEPTH

    def nrm(k, shape, s):
        return jax.random.normal(k, shape, f32) * s

    return {
        "x": nrm(ks[0], (BATCH, SEQ, D_MODEL), 1.0),
        "c": nrm(ks[1], (BATCH, D_MODEL), 1.0),
        "ada_w": nrm(ks[2], (L, D_MODEL, 6 * D_MODEL), 0.5 * D_MODEL ** -0.5),
        "ada_b": nrm(ks[3], (L, 6 * D_MODEL), 0.01),
        "norm1_g": 1.0 + nrm(ks[4], (L, D_MODEL), 0.01),
        "w_in": nrm(ks[5], (L, D_MODEL, IN_COLS), D_MODEL ** -0.5),
        "rwkv_mu": jax.random.uniform(ks[6], (L, RWKV_COLS), f32),
        "rwkv_w0": jax.random.uniform(ks[7], (L, RWKV_DIM), f32, -4.0, 0.0),
        "rwkv_w_up": nrm(ks[8], (L, DECAY_LORA, RWKV_DIM), 0.5 * DECAY_LORA ** -0.5),
        "rwkv_a0": nrm(ks[9], (L, RWKV_DIM), 0.1),
        "rwkv_a_up": nrm(ks[10], (L, AAA_LORA, RWKV_DIM), 0.5 * AAA_LORA ** -0.5),
        "rwkv_g_up": nrm(ks[11], (L, GATE_LORA, RWKV_DIM), GATE_LORA ** -0.5),
        "rwkv_k_k": 0.85 + nrm(ks[12], (L, RWKV_DIM), 0.02),
        "rwkv_k_a": 1.0 + nrm(ks[13], (L, RWKV_DIM), 0.02),
        "rwkv_r_k": nrm(ks[14], (L, RWKV_HEADS, RWKV_HEAD_DIM), 0.1),
        "rwkv_gn_w": 1.0 + nrm(ks[15], (L, RWKV_DIM), 0.01),
        "rwkv_gn_b": nrm(ks[16], (L, RWKV_DIM), 0.01),
        "attn_sinks": nrm(ks[17], (L, ATTN_HEADS), 1.0),
        "w_branch_a": nrm(ks[18], (L, RWKV_DIM, D_MODEL), RWKV_DIM ** -0.5),
        "w_branch_b": nrm(ks[19], (L, ATTN_DIM, D_MODEL), ATTN_DIM ** -0.5),
        "w_out": nrm(ks[20], (L, D_MODEL, D_MODEL), D_MODEL ** -0.5),
        "norm2_g": 1.0 + nrm(ks[21], (L, D_MODEL), 0.01),
        "ffn_w_up": nrm(ks[22], (L, D_MODEL, 2 * D_FF), D_MODEL ** -0.5),
        "ffn_conv_w": nrm(ks[23], (L, CONV_WIDTH, D_FF), CONV_WIDTH ** -0.5),
        "ffn_conv_b": nrm(ks[24], (L, D_FF), 0.01),
        "ffn_w_down": nrm(ks[25], (L, D_FF, D_MODEL), D_FF ** -0.5),
        "final_g": 1.0 + nrm(ks[26], (D_MODEL,), 0.01),
    }


def reference(x, c, ada_w, ada_b, norm1_g, w_in, rwkv_mu, rwkv_w0, rwkv_w_up, rwkv_a0, rwkv_a_up,
              rwkv_g_up, rwkv_k_k, rwkv_k_a, rwkv_r_k, rwkv_gn_w, rwkv_gn_b, attn_sinks, w_branch_a,
              w_branch_b, w_out, norm2_g, ffn_w_up, ffn_conv_w, ffn_conv_b, ffn_w_down, final_g):
    bsz, seq, _ = x.shape
    h = x
    c_act = jax.nn.silu(c)
    for l in range(DEPTH):
        mod = (c_act @ ada_w[l] + ada_b[l])[:, None, :]
        sh1, sc1, g1, sh2, sc2, g2 = jnp.split(mod, 6, axis=-1)

        u = rms_norm(h, norm1_g[l]) * (1.0 + sc1) + sh1
        proj = u @ w_in[l]
        f_rwkv, f_attn, gate_a, gate_b = jnp.split(proj, IN_SPLITS, axis=-1)

        y_a = rwkv7_branch(f_rwkv, rwkv_mu[l], rwkv_w0[l], rwkv_w_up[l], rwkv_a0[l], rwkv_a_up[l],
                           rwkv_g_up[l], rwkv_k_k[l], rwkv_k_a[l], rwkv_r_k[l], rwkv_gn_w[l],
                           rwkv_gn_b[l])

        q, k, v = jnp.split(f_attn, ATTN_SPLITS, axis=-1)
        y_b = swa_sink_attention(q.reshape(bsz, seq, ATTN_HEADS, ATTN_HEAD_DIM),
                                 k.reshape(bsz, seq, ATTN_KV_HEADS, ATTN_HEAD_DIM),
                                 v.reshape(bsz, seq, ATTN_KV_HEADS, ATTN_HEAD_DIM),
                                 attn_sinks[l])

        merged = (jax.nn.sigmoid(gate_a) * (y_a @ w_branch_a[l])
                  + jax.nn.sigmoid(gate_b) * (y_b @ w_branch_b[l]))
        h = h + g1 * (merged @ w_out[l])

        u2 = rms_norm(h, norm2_g[l]) * (1.0 + sc2) + sh2
        h = h + g2 * conv_gated_ffn(u2, ffn_w_up[l], ffn_conv_w[l], ffn_conv_b[l], ffn_w_down[l])
    return rms_norm(h, final_g)
```

```cpp
#include <hip/hip_runtime.h>
#include <hip/hip_cooperative_groups.h>
#include <cstdio>
#include <cstdint>
namespace cg = cooperative_groups;
namespace pg8 {
#define PG8_LAS __attribute__((address_space(3)))
typedef unsigned short bf16_t;
typedef short bf16x8 __attribute__((ext_vector_type(8)));
typedef float f32x4 __attribute__((ext_vector_type(4)));
typedef unsigned u32x4 __attribute__((ext_vector_type(4)));
constexpr int BM = 256, BK = 64, HALF = 128, HTB = HALF * BK * 2  , STAGE_BYTES = 8 * HTB, NXCD = 8, WGM = 8;

__host__ __device__ __forceinline__ int lds_byte(int r, int c) { const int st = (r >> 4) * 2 + (c >> 5), rr = r & 15, cc = c & 31, ob = rr * 64 + cc * 2; return st * 1024 + (ob ^ (((ob >> 9) & 1) << 5)); }
__host__ __device__ __forceinline__ void stage_rc(int b, int& R, int& C) { const int st = b / 1024, sb = b % 1024, swz = sb ^ (((sb >> 9) & 1) << 5); R = (st >> 1) * 16 + swz / 64; C = (st & 1) * 32 + (swz % 64) / 2; }
__host__ __device__ __forceinline__ int perm32(int rho) { const int n = rho >> 4, i = rho & 15; return 8 * (i >> 2) + 4 * n + (i & 3); }

struct Unit { int pm, pn; };
struct Gemm { const bf16_t* A; const bf16_t* Bt; int M, N, K, lda; };

struct StaticOrder {
    int nM, nN, nwg, G, c;
    __host__ __device__ void init(int M, int N, int G_, int c_) { nM = M / BM; nN = N / BM; nwg = nM * nN; G = G_; c = c_; }
    __host__ __device__ bool next(int i, Unit& u) const {
        const long L = (long)i * G + c; if (L >= nwg) return false;
        int wgid = (int)L; { const int q = nwg / NXCD, r = nwg % NXCD, xcd = wgid % NXCD, off = wgid / NXCD; wgid = (xcd < r ? xcd * (q + 1) : r * (q + 1) + (xcd - r) * q) + off; }
        const int nig = WGM * nN, gid = wgid / nig, fm = gid * WGM, gsz = (nM - fm) < WGM ? (nM - fm) : WGM;
        u.pm = fm + ((wgid % nig) % gsz); u.pn = (wgid % nig) / gsz; return true;
    }
    __device__ __forceinline__ void a_ready(const Unit&) const {}
    __device__ __forceinline__ void done(const Unit&) const {}
};


__device__ __forceinline__ unsigned cvt_pk_bf16(float lo, float hi) { unsigned r; asm volatile("v_cvt_pk_bf16_f32 %0, %1, %2" : "=v"(r) : "v"(lo), "v"(hi)); return r; }
template <class Epi, class Sched, bool ALIGN_EPI = false>
__device__ __forceinline__ void gemm_phase(PG8_LAS unsigned char* lds, const Gemm g, const Sched& S, const Epi& E) {
    const int tid = threadIdx.x, wid = __builtin_amdgcn_readfirstlane(tid >> 6), lane = tid & 63, wr = wid >> 2, wc = wid & 3, fr = lane & 15, fq = lane >> 4;
    const int K = g.K, nt = K / BK;
    unsigned voffA[2], voffB[2];
#pragma unroll
    for (int i = 0; i < 2; ++i) { int R, C; stage_rc(tid * 16 + i * 8192, R, C); const int Rb = Epi::PERM ? ((R & ~31) + perm32(R & 31)) : R;
        voffA[i] = (unsigned)(R * g.lda + C) * 2u; voffB[i] = (unsigned)(Rb * K + C) * 2u; }
    const size_t kstep = (size_t)(BK * 2);
    const size_t hstepA = (size_t)HALF * g.lda * 2, hstepB = (size_t)HALF * K * 2;
    const size_t tstepA = 2 * hstepA, tstepB = 2 * hstepB;
    const unsigned ldsw = (unsigned)wid * 1024u;
    const int aoff = lds_byte(wr * 64 + fr, fq * 8), boff = lds_byte(wc * 32 + fr, fq * 8);
#define PG8_SA(b, h) (((b) * 2 + (h)) * HTB)
#define PG8_SB(b, h) ((4 + (b) * 2 + (h)) * HTB)
#define PG8_STAGE(bufoff, gbase, voff) do { _Pragma("unroll") for (int _i = 0; _i < 2; ++_i) \
        __builtin_amdgcn_global_load_lds((const unsigned*)((const char*)(gbase) + (voff)[_i]), (PG8_LAS unsigned*)(lds + (bufoff) + ldsw + _i * 8192), 16, 0, 0); } while (0)
#define PG8_LDA(dst, b, h) do { _Pragma("unroll") for (int m = 0; m < 4; ++m) _Pragma("unroll") for (int k = 0; k < 2; ++k) dst[m][k] = *(const PG8_LAS bf16x8*)(lds + PG8_SA(b, h) + aoff + m * 2048 + k * 1024); } while (0)
#define PG8_LDB(dst, b, h) do { _Pragma("unroll") for (int n = 0; n < 2; ++n) _Pragma("unroll") for (int k = 0; k < 2; ++k) dst[n][k] = *(const PG8_LAS bf16x8*)(lds + PG8_SB(b, h) + boff + n * 2048 + k * 1024); } while (0)
#define PG8_MMA(ai, bj, At, Bt) do { __builtin_amdgcn_s_setprio(1); _Pragma("unroll") for (int m = 0; m < 4; ++m) _Pragma("unroll") for (int n = 0; n < 2; ++n) _Pragma("unroll") for (int k = 0; k < 2; ++k) \
        acc[ai][bj][m][n] = __builtin_amdgcn_mfma_f32_16x16x32_bf16(Bt[n][k], At[m][k], acc[ai][bj][m][n], 0, 0, 0); __builtin_amdgcn_s_setprio(0); } while (0)
#define PG8_WAIT_V(n) asm volatile("s_waitcnt vmcnt(" #n ")" ::: "memory")
#define PG8_WAIT_L(n) asm volatile("s_waitcnt lgkmcnt(" #n ")" ::: "memory")
#define PG8_BAR __builtin_amdgcn_s_barrier()
#define PG8_SCHED __builtin_amdgcn_sched_barrier(0)
    Unit cur, nxt; int ui = 0;
    if (!S.next(0, cur)) return;
    f32x4 acc[2][2][4][2];
#pragma unroll
    for (int a = 0; a < 2; ++a)
#pragma unroll
        for (int b = 0; b < 2; ++b)
#pragma unroll
            for (int m = 0; m < 4; ++m)
#pragma unroll
                for (int n = 0; n < 2; ++n) acc[a][b][m][n] = (f32x4){0.f, 0.f, 0.f, 0.f};
    bf16x8 At[4][2], B0[2][2], B1[2][2];
    const char* cA = (const char*)g.A + (size_t)cur.pm * tstepA; const char* cB = (const char*)g.Bt + (size_t)cur.pn * tstepB;
    S.a_ready(cur);
    {
        PG8_STAGE(PG8_SB(0, 0), cB, voffB); PG8_STAGE(PG8_SB(0, 1), cB + hstepB, voffB); PG8_STAGE(PG8_SA(0, 0), cA, voffA); PG8_STAGE(PG8_SA(0, 1), cA + hstepA, voffA);
        if (wr == 1) PG8_BAR;
        PG8_WAIT_V(2); PG8_BAR;
        PG8_STAGE(PG8_SB(1, 0), cB + kstep, voffB); PG8_STAGE(PG8_SA(1, 0), cA + kstep, voffA); PG8_STAGE(PG8_SB(1, 1), cB + hstepB + kstep, voffB);
        PG8_WAIT_V(6); PG8_BAR;
    }
    for (;;) {
        const bool has_next = S.next(ui + 1, nxt);
        const char* nA = has_next ? (const char*)g.A + (size_t)nxt.pm * tstepA : cA; const char* nB = has_next ? (const char*)g.Bt + (size_t)nxt.pn * tstepB : cB;
        for (int t = 0; t < nt; t += 2) {
            if constexpr (Epi::MIDK) { if (t == (nt >> 1)) E.mid(acc, cur, wr, wc, fr, fq); }
            const bool last = (t == nt - 2);
            const char* a1 = cA + (size_t)(t + 1) * kstep;
            const char* a2 = last ? nA : cA + (size_t)(t + 2) * kstep; const char* b2 = last ? nB : cB + (size_t)(t + 2) * kstep;
            const char* a3 = a2 + kstep; const char* b3 = b2 + kstep;
            if (last && has_next) S.a_ready(nxt);
            {
            PG8_LDB(B0, 0, 0); PG8_LDB(B1, 0, 1); PG8_SCHED; PG8_LDA(At, 0, 0); PG8_STAGE(PG8_SA(1, 1), a1 + hstepA, voffA);
            PG8_WAIT_V(8); PG8_WAIT_L(0); PG8_BAR; PG8_MMA(0, 0, At, B0); PG8_MMA(0, 1, At, B1); PG8_BAR; PG8_SCHED;
            PG8_LDA(At, 0, 1); PG8_STAGE(PG8_SB(0, 0), b2, voffB); PG8_STAGE(PG8_SB(0, 1), b2 + hstepB, voffB); PG8_STAGE(PG8_SA(0, 0), a2, voffA);
            PG8_WAIT_V(8); PG8_WAIT_L(0); PG8_BAR; PG8_MMA(1, 0, At, B0); PG8_MMA(1, 1, At, B1); PG8_BAR; PG8_SCHED;
            PG8_LDB(B0, 1, 0); PG8_LDB(B1, 1, 1); PG8_SCHED; PG8_LDA(At, 1, 0); PG8_STAGE(PG8_SA(0, 1), a2 + hstepA, voffA);
            PG8_WAIT_V(8); PG8_WAIT_L(0); PG8_BAR; PG8_MMA(0, 0, At, B0); PG8_MMA(0, 1, At, B1); PG8_BAR; PG8_SCHED;
            PG8_LDA(At, 1, 1); PG8_STAGE(PG8_SB(1, 0), b3, voffB); PG8_STAGE(PG8_SB(1, 1), b3 + hstepB, voffB); PG8_STAGE(PG8_SA(1, 0), a3, voffA);
            PG8_WAIT_V(8); PG8_WAIT_L(0); PG8_BAR; PG8_MMA(1, 0, At, B0); PG8_MMA(1, 1, At, B1); PG8_BAR; PG8_SCHED;
            }
        }
        if constexpr (ALIGN_EPI) { if (wr == 0) PG8_BAR; }
        if constexpr (!Epi::AFTER_DRAIN) { E(acc, cur, wr, wc, fr, fq); S.done(cur); }
        if (!has_next) break;
#pragma unroll
        for (int a = 0; a < 2; ++a)
#pragma unroll
            for (int b = 0; b < 2; ++b)
#pragma unroll
                for (int m = 0; m < 4; ++m)
#pragma unroll
                    for (int n = 0; n < 2; ++n) acc[a][b][m][n] = (f32x4){0.f, 0.f, 0.f, 0.f};
        cur = nxt; cA = nA; cB = nB; ++ui;
        if constexpr (ALIGN_EPI) { if (wr == 1) PG8_BAR; }
    }
    PG8_WAIT_V(0);
    if constexpr (!ALIGN_EPI) { if (wr == 0) PG8_BAR; }
    PG8_BAR;
    if constexpr (Epi::AFTER_DRAIN) { E.fused(acc, cur, wr, wc, fr, fq, lds, wid, lane); S.done(cur); }
#undef PG8_SA
#undef PG8_SB
#undef PG8_STAGE
#undef PG8_LDA
#undef PG8_LDB
#undef PG8_MMA
#undef PG8_WAIT_V
#undef PG8_WAIT_L
#undef PG8_BAR
#undef PG8_SCHED
}
}

constexpr int DM = 1024, NB = 16, SEQ = 2048, M = NB * SEQ;
constexpr int RW = 512, RWKV_COLS = 1792, ATTN_COLS = 768, IN_COLS = 4608, DFF = 2816;
constexpr int NWAVES = 8, NTHR = 512;
constexpr size_t MiB = 1u << 20;
constexpr size_t WS_MOD = 0;
constexpr size_t WS_CTL = 512 * 1024, CTL_BYTES = 131072;
constexpr size_t WS_FIXL = 408 * MiB, WS_TAILL = 409 * MiB;
constexpr size_t WS_G = 410 * MiB;
constexpr size_t WS_H1B = 330 * MiB;
constexpr size_t WS_SLOT1 = 316 * MiB, WS_SLOT2 = 318 * MiB;
constexpr size_t WS_WIN = 1 * MiB;
constexpr size_t WS_WLORA = 10 * MiB;
constexpr size_t WS_WA = 11 * MiB;
constexpr size_t WS_WB = 12 * MiB;
constexpr size_t WS_WOUT = 13 * MiB;
constexpr size_t WS_WUP = 15 * MiB;
constexpr size_t WS_WDN = 26 * MiB;
constexpr size_t WS_U = 40 * MiB;
constexpr size_t WS_PG = 104 * MiB;
constexpr size_t WS_PR = 232 * MiB;
constexpr size_t WS_PQKV = 344 * MiB;
constexpr size_t WS_LA = 392 * MiB;
constexpr size_t WS_TMP = 408 * MiB;
constexpr size_t WS_ASIG = 472 * MiB;
constexpr size_t WS_ACT = 104 * MiB;
constexpr size_t WS_FIXG = 300 * MiB, WS_FIXV = 304 * MiB, WS_TAILG = 308 * MiB;
constexpr size_t WS_END = 504 * MiB;

#define LAS __attribute__((address_space(3)))
typedef unsigned short bf16;
typedef float f32x4 __attribute__((ext_vector_type(4)));
typedef float f32x2 __attribute__((ext_vector_type(2)));
typedef float f32x16 __attribute__((ext_vector_type(16)));
typedef unsigned u32x4 __attribute__((ext_vector_type(4)));
typedef unsigned u32x2 __attribute__((ext_vector_type(2)));
typedef short bf16x8 __attribute__((ext_vector_type(8)));
typedef short s16x4 __attribute__((ext_vector_type(4)));

__device__ __forceinline__ float bflo(unsigned w) { return __uint_as_float(w << 16); }
__device__ __forceinline__ float bfhi(unsigned w) { return __uint_as_float(w & 0xffff0000u); }
typedef float f32x2c_t __attribute__((ext_vector_type(2))); typedef __bf16 bf16x2c_t __attribute__((ext_vector_type(2)));
__device__ __forceinline__ unsigned pk2(float lo, float hi) { const f32x2c_t v = {lo, hi}; const bf16x2c_t b = __builtin_convertvector(v, bf16x2c_t); return __builtin_bit_cast(unsigned, b); }
__device__ __forceinline__ float sigmoidf_(float x) { return 1.0f / (1.0f + __expf(-x)); }
__device__ __forceinline__ float sigmoid_fast(float x) { return __builtin_amdgcn_rcpf(1.0f + __expf(-x)); }
__device__ __forceinline__ float wave_sum(float v) {
#pragma unroll
    for (int o = 1; o < 64; o <<= 1) v += __shfl_xor(v, o);
    return v;
}
template <int CTRL> __device__ __forceinline__ float dppf(float x) { return __builtin_bit_cast(float, __builtin_amdgcn_mov_dpp(__builtin_bit_cast(int, x), CTRL, 0xf, 0xf, true)); }
__device__ __forceinline__ float sum16(float x) { x += dppf<0xB1>(x); x += dppf<0x4E>(x); x += dppf<0x141>(x); x += dppf<0x128>(x); return x; }

enum { EP_PROJ = 0, EP_LORA = 1, EP_BA = 2, EP_BB = 3, EP_WO = 4, EP_UP = 5, EP_DOWN = 6 };
template <int MODE> struct Epi {
    static constexpr bool PERM = true, AFTER_DRAIN = false, MIDK = false;
    bf16* o0; bf16* o1; bf16* o2; float* of; const float* p0; const float* p1; const bf16* q0; const float* mod;
    __device__ __forceinline__ void operator()(const f32x4 (&acc)[2][2][4][2], const pg8::Unit& u, int wr, int wc, int fr, int fq) const {
        asm volatile("" : "+v"(fr), "+v"(fq));
#pragma unroll
        for (int ai = 0; ai < 2; ++ai)
#pragma unroll
            for (int m = 0; m < 4; ++m) {
                const int row = u.pm * 256 + ai * 128 + wr * 64 + m * 16 + fr;
#pragma unroll
                for (int bj = 0; bj < 2; ++bj) {
                    const int col = u.pn * 256 + bj * 128 + wc * 32 + 8 * fq;
                    f32x4 v0 = acc[ai][bj][m][0], v1 = acc[ai][bj][m][1];
                    if constexpr (MODE == EP_PROJ) {
                        bf16* dst;
                        if (u.pn < 7) dst = o0 + (size_t)row * RWKV_COLS + col;
                        else if (u.pn < 10) dst = o1 + (size_t)row * ATTN_COLS + (col - RWKV_COLS);
                        else {
                            if (bj == 0) continue;
                            const int jq = 128 * (u.pn - 10) + wc * 32 + 8 * fq;
                            const f32x4 a0 = acc[ai][0][m][0], a1 = acc[ai][0][m][1];
                            f32x4 r0v, r1v;
#pragma unroll
                            for (int i = 0; i < 4; ++i) {
                                const float ea0 = 1.0f + __builtin_amdgcn_exp2f(a0[i]), eb0 = 1.0f + __builtin_amdgcn_exp2f(v0[i]), ea1 = 1.0f + __builtin_amdgcn_exp2f(a1[i]), eb1 = 1.0f + __builtin_amdgcn_exp2f(v1[i]);
                                r0v[i] = eb0 * __builtin_amdgcn_rcpf(ea0); r1v[i] = eb1 * __builtin_amdgcn_rcpf(ea1);
                                v0[i] = __builtin_amdgcn_rcpf(eb0); v1[i] = __builtin_amdgcn_rcpf(eb1);
                            }
                            u32x4 wr_; wr_.x = pk2(r0v[0], r0v[1]); wr_.y = pk2(r0v[2], r0v[3]); wr_.z = pk2(r1v[0], r1v[1]); wr_.w = pk2(r1v[2], r1v[3]);
                            *(u32x4*)(o2 + (size_t)row * 2048 + jq) = wr_;
                            dst = o2 + (size_t)row * 2048 + 1024 + jq;
                        }
                        u32x4 w; w.x = pk2(v0[0], v0[1]); w.y = pk2(v0[2], v0[3]); w.z = pk2(v1[0], v1[1]); w.w = pk2(v1[2], v1[3]);
                        *(u32x4*)dst = w;
                    } else if constexpr (MODE == EP_LORA) {
                        if (u.pn < 2) {
                            const f32x4 b0 = *(const f32x4*)(p0 + col), b1 = *(const f32x4*)(p0 + col + 4);
                            f32x4 r0, r1;
#pragma unroll
                            for (int i = 0; i < 4; ++i) {
                                r0[i] = __builtin_amdgcn_exp2f(-0.87503877f * sigmoid_fast(b0[i] + v0[i]));
                                r1[i] = __builtin_amdgcn_exp2f(-0.87503877f * sigmoid_fast(b1[i] + v1[i]));
                            }
                            float* d = of + (size_t)row * RW + col; *(f32x4*)d = r0; *(f32x4*)(d + 4) = r1;
                        } else if (u.pn < 4) {
                            const int c = col - 512;
                            const f32x4 b0 = *(const f32x4*)(p1 + c), b1 = *(const f32x4*)(p1 + c + 4);
#pragma unroll
                            for (int i = 0; i < 4; ++i) { v0[i] = sigmoid_fast(v0[i] + b0[i]); v1[i] = sigmoid_fast(v1[i] + b1[i]); }
                            u32x4 w; w.x = pk2(v0[0], v0[1]); w.y = pk2(v0[2], v0[3]); w.z = pk2(v1[0], v1[1]); w.w = pk2(v1[2], v1[3]);
                            *(u32x4*)(o0 + (size_t)row * RW + c) = w;
                        } else {
                            const int c = col - 1024;
                            u32x4 w; w.x = pk2(v0[0], v0[1]); w.y = pk2(v0[2], v0[3]); w.z = pk2(v1[0], v1[1]); w.w = pk2(v1[2], v1[3]);
                            *(u32x4*)(o1 + (size_t)row * RW + c) = w;
                        }
                    } else if constexpr (MODE == EP_BA || MODE == EP_BB) {
                        const u32x4 gt = *(const u32x4*)(q0 + (size_t)row * 2048 + (MODE == EP_BB ? 1024 : 0) + col);
                        v0[0] *= bflo(gt.x); v0[1] *= bfhi(gt.x); v0[2] *= bflo(gt.y); v0[3] *= bfhi(gt.y);
                        v1[0] *= bflo(gt.z); v1[1] *= bfhi(gt.z); v1[2] *= bflo(gt.w); v1[3] *= bfhi(gt.w);
                        if constexpr (MODE == EP_BB) {
                            const u32x4 t = *(const u32x4*)(o1 + (size_t)row * DM + col);
                            v0[0] += bflo(t.x); v0[1] += bfhi(t.x); v0[2] += bflo(t.y); v0[3] += bfhi(t.y);
                            v1[0] += bflo(t.z); v1[1] += bfhi(t.z); v1[2] += bflo(t.w); v1[3] += bfhi(t.w);
                        }
                        u32x4 w; w.x = pk2(v0[0], v0[1]); w.y = pk2(v0[2], v0[3]); w.z = pk2(v1[0], v1[1]); w.w = pk2(v1[2], v1[3]);
                        *(u32x4*)(o0 + (size_t)row * DM + col) = w;
                    } else if constexpr (MODE == EP_WO || MODE == EP_DOWN) {
                        const int b = row >> 11;
                        const float* gp = mod + b * 6144 + (MODE == EP_WO ? 2048 : 5120) + col;
                        const f32x4 g0 = *(const f32x4*)gp, g1 = *(const f32x4*)(gp + 4);
                        const float* xp = p0 + (size_t)row * DM + col;
                        const f32x4 x0 = *(const f32x4*)xp, x1 = *(const f32x4*)(xp + 4);
                        float* d = of + (size_t)row * DM + col;
                        *(f32x4*)d = x0 + g0 * v0; *(f32x4*)(d + 4) = x1 + g1 * v1;
                    } else if constexpr (MODE == EP_UP) {
                        u32x4 w; w.x = pk2(v0[0], v0[1]); w.y = pk2(v0[2], v0[3]); w.z = pk2(v1[0], v1[1]); w.w = pk2(v1[2], v1[3]);
                        *(u32x4*)(o0 + (size_t)row * (2 * DFF) + col) = w;
                    }
                    __builtin_amdgcn_sched_barrier(0);
                }
            }
    }
};


struct EpiUp {
    static constexpr bool PERM = true, AFTER_DRAIN = false, MIDK = false;
    bf16* act; float* fixg; float* fixv; float* tailg; const float* cw; const float* cb; LAS float* X;
    template <int CTRL> static __device__ __forceinline__ f32x4 rot(f32x4 v) { return (f32x4){dppf<CTRL>(v.x), dppf<CTRL>(v.y), dppf<CTRL>(v.z), dppf<CTRL>(v.w)}; }
    static __device__ __forceinline__ f32x4 sel(bool c, f32x4 a, f32x4 b) { return (f32x4){c ? a.x : b.x, c ? a.y : b.y, c ? a.z : b.z, c ? a.w : b.w}; }
    static __device__ __forceinline__ f32x4 nsilu(f32x4 zp) {
        f32x4 y;
#pragma unroll
        for (int i = 0; i < 4; ++i) y[i] = zp[i] * __builtin_amdgcn_rcpf(1.0f + __builtin_amdgcn_exp2f(zp[i]));
        return y;
    }
    static __device__ __forceinline__ f32x4 siluv(f32x4 z) { return (f32x4){z.x * sigmoid_fast(z.x), z.y * sigmoid_fast(z.y), z.z * sigmoid_fast(z.z), z.w * sigmoid_fast(z.w)}; }
    __device__ __forceinline__ void operator()(const f32x4 (&acc)[2][2][4][2], const pg8::Unit& u, int wr, int wc, int fr, int fq) const {
        asm volatile("" : "+v"(fr), "+v"(fq));
        const int chl = wc * 32 + 8 * fq, ch = u.pn * 128 + chl;
        if (fr >= 14) {
#pragma unroll
            for (int ai = 0; ai < 2; ++ai) { LAS float* x = X + ((ai * 2 + wr) * 2 + (fr - 14)) * 128 + chl; *(LAS f32x4*)x = acc[ai][0][3][0]; *(LAS f32x4*)(x + 4) = acc[ai][0][3][1]; }
        }
        asm volatile("s_waitcnt lgkmcnt(0)\n\ts_barrier" ::: "memory");
        constexpr float NL2E = -1.4426950408889634f;
        const f32x4 w0a = *(const f32x4*)(cw + ch) * NL2E, w0b = *(const f32x4*)(cw + ch + 4) * NL2E, w1a = *(const f32x4*)(cw + DFF + ch) * NL2E, w1b = *(const f32x4*)(cw + DFF + ch + 4) * NL2E;
        const f32x4 w2a = *(const f32x4*)(cw + 2 * DFF + ch) * NL2E, w2b = *(const f32x4*)(cw + 2 * DFF + ch + 4) * NL2E, ba = *(const f32x4*)(cb + ch) * NL2E, bb = *(const f32x4*)(cb + ch + 4) * NL2E;
        const bool seq_start = (u.pm & 7) == 0;
#pragma unroll
        for (int ai = 0; ai < 2; ++ai) {
            const int grp = ai * 2 + wr;
            f32x4 p1a = (f32x4){0.f, 0.f, 0.f, 0.f}, p1b = p1a, p2a = p1a, p2b = p1a;
            if (grp > 0) {
                const LAS float* x = X + ((grp - 1) * 2) * 128 + chl;
                const f32x4 x14a = *(const LAS f32x4*)x, x14b = *(const LAS f32x4*)(x + 4), x15a = *(const LAS f32x4*)(x + 128), x15b = *(const LAS f32x4*)(x + 132);
                p1a = x15a; p1b = x15b; p2a = sel(fr == 0, x14a, x15a); p2b = sel(fr == 0, x14b, x15b);
            }
#pragma unroll
            for (int m = 0; m < 4; ++m) {
                const f32x4 g0a = acc[ai][0][m][0], g0b = acc[ai][0][m][1], va = acc[ai][1][m][0], vb = acc[ai][1][m][1];
                const f32x4 c1a = rot<0x121>(g0a), c1b = rot<0x121>(g0b), c2a = rot<0x122>(g0a), c2b = rot<0x122>(g0b);
                const f32x4 g1a = sel(fr >= 1, c1a, p1a), g1b = sel(fr >= 1, c1b, p1b), g2a = sel(fr >= 2, c2a, p2a), g2b = sel(fr >= 2, c2b, p2b);
                const f32x4 za = w0a * g2a + w1a * g1a + w2a * g0a + ba, zb = w0b * g2b + w1b * g1b + w2b * g0b + bb;
                const f32x4 oa = nsilu(za) * va, ob = nsilu(zb) * vb;
                const int rl = ai * 128 + wr * 64 + m * 16 + fr;
                if (grp == 0 && m == 0 && fr < 2 && !seq_start) {
                    float* fg = fixg + (size_t)(u.pm * 2 + fr) * DFF + ch; float* fv = fixv + (size_t)(u.pm * 2 + fr) * DFF + ch;
                    *(f32x4*)fg = g0a; *(f32x4*)(fg + 4) = g0b; *(f32x4*)fv = va; *(f32x4*)(fv + 4) = vb;
                } else {
                    u32x4 w; w.x = pk2(oa.x, oa.y); w.y = pk2(oa.z, oa.w); w.z = pk2(ob.x, ob.y); w.w = pk2(ob.z, ob.w);
                    *(u32x4*)(act + (size_t)(u.pm * 256 + rl) * DFF + ch) = w;
                }
                p1a = c1a; p1b = c1b; p2a = c2a; p2b = c2b;
                __builtin_amdgcn_sched_barrier(0);
            }
        }
        if (wr == 1 && fr >= 14) { float* tg = tailg + (size_t)(u.pm * 2 + (fr - 14)) * DFF + ch; *(f32x4*)tg = acc[1][0][3][0]; *(f32x4*)(tg + 4) = acc[1][0][3][1]; }
    }
};


__device__ __forceinline__ float xrow16_sum(float x) {
    auto s = __builtin_amdgcn_permlane16_swap(__float_as_uint(x), __float_as_uint(x), false, false);
    x = __uint_as_float(s[0]) + __uint_as_float(s[1]);
    auto t = __builtin_amdgcn_permlane32_swap(__float_as_uint(x), __float_as_uint(x), false, false);
    return __uint_as_float(t[0]) + __uint_as_float(t[1]);
}
template <bool FINAL> struct EpiNorm {
    static constexpr bool PERM = true, AFTER_DRAIN = false, MIDK = false;
    const float* base; float* outf; bf16* outb; const float* mod; const float* gain; float* slots; unsigned* cnt; LAS float* T; bf16* hb;
    __device__ __forceinline__ void operator()(f32x4 (&acc)[2][2][4][2], const pg8::Unit& u, int wr, int wc, int fr, int fq) const {
        asm volatile("" : "+v"(fr), "+v"(fq));
        const int wid = wr * 4 + wc, lane = fq * 16 + fr;
        const int b = (u.pm * 256) >> 11;
        const float* mrow = mod + b * 6144;
        constexpr int GOFF = FINAL ? 5120 : 2048;
        unsigned tw = (unsigned)(unsigned long)(T + (wr * 64 + fr) * 4 + wc), ts = (unsigned)(unsigned long)(T + 1024 + wr * 64 + fr);
        asm volatile("" : "+v"(tw), "+v"(ts));
        const int colb = u.pn * 256 + wc * 32 + 8 * fq;
        f32x4 Gv[2][2];
#pragma unroll
        for (int bj = 0; bj < 2; ++bj) { Gv[bj][0] = *(const f32x4*)(mrow + GOFF + colb + 128 * bj); Gv[bj][1] = *(const f32x4*)(mrow + GOFF + colb + 128 * bj + 4); }
        const size_t roff = ((size_t)u.pm * 256 + wr * 64 + fr) * DM + colb;
        const float* bp = base + roff;
        const bf16* hp = hb + roff;
        f32x4 Xv[2][2][2]; u32x4 Hq[2][2];
#pragma unroll
        for (int bj = 0; bj < 2; ++bj) {
            if constexpr (FINAL) Hq[0][bj] = *(const u32x4*)(hp + 128 * bj);
            else { Xv[0][bj][0] = *(const f32x4*)(bp + 128 * bj); Xv[0][bj][1] = *(const f32x4*)(bp + 128 * bj + 4); }
        }
#pragma unroll
        for (int it = 0; it < 8; ++it) {
            const int ai = it >> 2, m = it & 3;
            if (it + 1 < 8) { const size_t no = (size_t)(((it + 1) >> 2) * 128 + ((it + 1) & 3) * 16) * DM;
#pragma unroll
                for (int bj = 0; bj < 2; ++bj) {
                    if constexpr (FINAL) Hq[(it + 1) & 1][bj] = *(const u32x4*)(hp + no + 128 * bj);
                    else { Xv[(it + 1) & 1][bj][0] = *(const f32x4*)(bp + no + 128 * bj); Xv[(it + 1) & 1][bj][1] = *(const f32x4*)(bp + no + 128 * bj + 4); }
                } }
            const size_t row = (size_t)u.pm * 256 + ai * 128 + wr * 64 + m * 16 + fr;
            float ss = 0.f;
#pragma unroll
            for (int bj = 0; bj < 2; ++bj) {
                f32x4 x0, x1;
                if constexpr (FINAL) { const u32x4 q = Hq[it & 1][bj]; x0 = (f32x4){bflo(q.x), bfhi(q.x), bflo(q.y), bfhi(q.y)}; x1 = (f32x4){bflo(q.z), bfhi(q.z), bflo(q.w), bfhi(q.w)}; }
                else { x0 = Xv[it & 1][bj][0]; x1 = Xv[it & 1][bj][1]; }
                const f32x4 h0 = x0 + Gv[bj][0] * acc[ai][bj][m][0], h1 = x1 + Gv[bj][1] * acc[ai][bj][m][1];
                acc[ai][bj][m][0] = h0; acc[ai][bj][m][1] = h1;
                ss += (h0.x * h0.x + h0.y * h0.y) + (h0.z * h0.z + h0.w * h0.w) + (h1.x * h1.x + h1.y * h1.y) + (h1.z * h1.z + h1.w * h1.w);
                if constexpr (!FINAL) { u32x4 w; w.x = pk2(h0.x, h0.y); w.y = pk2(h0.z, h0.w); w.z = pk2(h1.x, h1.y); w.w = pk2(h1.z, h1.w); *(u32x4*)(hb + row * DM + colb + 128 * bj) = w; }
            }
            ss = xrow16_sum(ss);
            if (fq == 0) *(LAS float*)(unsigned long)(tw + (ai * 128 + m * 16) * 16) = ss;
            __builtin_amdgcn_sched_barrier(0);
        }
        asm volatile("s_waitcnt lgkmcnt(0)\n\ts_barrier" ::: "memory");
        const int r = wid * 32 + (lane & 31);
        if (lane < 32) {
            const f32x4 p = *(const LAS f32x4*)(T + r * 4);
            __hip_atomic_store(slots + ((size_t)u.pm * 256 + r) * 4 + u.pn, (p.x + p.y) + (p.z + p.w), __ATOMIC_RELAXED, __HIP_MEMORY_SCOPE_AGENT);
        }
        asm volatile("s_waitcnt vmcnt(0)" ::: "memory");
        unsigned* pc = cnt + 64 * u.pm;
        if (lane == 0) __hip_atomic_fetch_add(pc, 1u, __ATOMIC_RELAXED, __HIP_MEMORY_SCOPE_AGENT);
        if (wid == 0) {
            unsigned sp = 0;
            while ((unsigned)__builtin_amdgcn_readfirstlane((int)__hip_atomic_load(pc, __ATOMIC_RELAXED, __HIP_MEMORY_SCOPE_AGENT)) < 32u) { __builtin_amdgcn_s_sleep(2); if (++sp > (1u << 20)) break; }
            __builtin_amdgcn_fence(__ATOMIC_ACQUIRE, "agent");
        }
        asm volatile("s_waitcnt vmcnt(0) lgkmcnt(0)\n\ts_barrier" ::: "memory");
        if (lane < 32) {
            const float* sl = slots + ((size_t)u.pm * 256 + r) * 4;
            const float q = (__hip_atomic_load(sl, __ATOMIC_RELAXED, __HIP_MEMORY_SCOPE_AGENT) + __hip_atomic_load(sl + 1, __ATOMIC_RELAXED, __HIP_MEMORY_SCOPE_AGENT))
                          + (__hip_atomic_load(sl + 2, __ATOMIC_RELAXED, __HIP_MEMORY_SCOPE_AGENT) + __hip_atomic_load(sl + 3, __ATOMIC_RELAXED, __HIP_MEMORY_SCOPE_AGENT));
            T[1024 + r] = rsqrtf(q * (1.0f / DM) + 1e-6f);
        }
        asm volatile("s_waitcnt vmcnt(0) lgkmcnt(0)\n\ts_barrier" ::: "memory");
        f32x4 Nv[2][2], SCv[2][2], SHv[2][2];
#pragma unroll
        for (int bj = 0; bj < 2; ++bj) {
            Nv[bj][0] = *(const f32x4*)(gain + colb + 128 * bj); Nv[bj][1] = *(const f32x4*)(gain + colb + 128 * bj + 4);
            if constexpr (!FINAL) {
                SCv[bj][0] = *(const f32x4*)(mrow + 4096 + colb + 128 * bj) + 1.0f; SCv[bj][1] = *(const f32x4*)(mrow + 4096 + colb + 128 * bj + 4) + 1.0f;
                SHv[bj][0] = *(const f32x4*)(mrow + 3072 + colb + 128 * bj); SHv[bj][1] = *(const f32x4*)(mrow + 3072 + colb + 128 * bj + 4);
                Nv[bj][0] = Nv[bj][0] * SCv[bj][0]; Nv[bj][1] = Nv[bj][1] * SCv[bj][1];
            }
        }
#pragma unroll
        for (int ai = 0; ai < 2; ++ai)
#pragma unroll
            for (int m = 0; m < 4; ++m) {
                const int rl = ai * 128 + wr * 64 + m * 16 + fr; const size_t row = (size_t)u.pm * 256 + rl;
                const float rstd = *(const LAS float*)(unsigned long)(ts + (ai * 128 + m * 16) * 4);
#pragma unroll
                for (int bj = 0; bj < 2; ++bj) {
                    const int col = colb + 128 * bj;
                    f32x4 o0 = acc[ai][bj][m][0] * rstd * Nv[bj][0], o1 = acc[ai][bj][m][1] * rstd * Nv[bj][1];
                    if constexpr (FINAL) { *(f32x4*)(outf + row * DM + col) = o0; *(f32x4*)(outf + row * DM + col + 4) = o1; }
                    else {
                        o0 = o0 + SHv[bj][0]; o1 = o1 + SHv[bj][1];
                        u32x4 w; w.x = pk2(o0.x, o0.y); w.y = pk2(o0.z, o0.w); w.z = pk2(o1.x, o1.y); w.w = pk2(o1.z, o1.w);
                        *(u32x4*)(outb + row * DM + col) = w;
                    }
                }
                __builtin_amdgcn_sched_barrier(0);
            }
    }
};


struct EpiBranch {
    static constexpr bool PERM = true, AFTER_DRAIN = false, MIDK = true;
    bf16* out; const bf16* pg;
    __device__ __forceinline__ void mid(f32x4 (&acc)[2][2][4][2], const pg8::Unit& u, int wr, int wc, int fr, int fq) const {
        asm volatile("" : "+v"(fr), "+v"(fq));
        const bf16* gp = pg + ((size_t)u.pm * 256 + wr * 64 + fr) * 2048 + u.pn * 256 + wc * 32 + 8 * fq;
        u32x4 Gr[2][2];
#pragma unroll
        for (int bj = 0; bj < 2; ++bj) Gr[0][bj] = *(const u32x4*)(gp + 128 * bj);
#pragma unroll
        for (int it = 0; it < 8; ++it) {
            const int ai = it >> 2, m = it & 3;
            if (it + 1 < 8) { const bf16* np = gp + (size_t)(((it + 1) >> 2) * 128 + ((it + 1) & 3) * 16) * 2048;
#pragma unroll
                for (int bj = 0; bj < 2; ++bj) Gr[(it + 1) & 1][bj] = *(const u32x4*)(np + 128 * bj); }
#pragma unroll
            for (int bj = 0; bj < 2; ++bj) {
                const u32x4 gr = Gr[it & 1][bj];
                f32x4& v0 = acc[ai][bj][m][0]; f32x4& v1 = acc[ai][bj][m][1];
                v0[0] *= bflo(gr.x); v0[1] *= bfhi(gr.x); v0[2] *= bflo(gr.y); v0[3] *= bfhi(gr.y);
                v1[0] *= bflo(gr.z); v1[1] *= bfhi(gr.z); v1[2] *= bflo(gr.w); v1[3] *= bfhi(gr.w);
            }
            __builtin_amdgcn_sched_barrier(0);
        }
    }
    __device__ __forceinline__ void operator()(const f32x4 (&acc)[2][2][4][2], const pg8::Unit& u, int wr, int wc, int fr, int fq) const {
        asm volatile("" : "+v"(fr), "+v"(fq));
        const size_t row0 = (size_t)u.pm * 256 + wr * 64 + fr; const int colb = u.pn * 256 + wc * 32 + 8 * fq;
        const bf16* gp = pg + row0 * 2048 + 1024 + colb;
        u32x4 Gb[2][2];
#pragma unroll
        for (int bj = 0; bj < 2; ++bj) Gb[0][bj] = *(const u32x4*)(gp + 128 * bj);
#pragma unroll
        for (int it = 0; it < 8; ++it) {
            const int ai = it >> 2, m = it & 3;
            if (it + 1 < 8) { const bf16* np = gp + (size_t)(((it + 1) >> 2) * 128 + ((it + 1) & 3) * 16) * 2048;
#pragma unroll
                for (int bj = 0; bj < 2; ++bj) Gb[(it + 1) & 1][bj] = *(const u32x4*)(np + 128 * bj); }
            const size_t row = row0 + ai * 128 + m * 16;
#pragma unroll
            for (int bj = 0; bj < 2; ++bj) {
                const u32x4 gb = Gb[it & 1][bj];
                const f32x4 v0 = acc[ai][bj][m][0], v1 = acc[ai][bj][m][1];
                u32x4 w; w.x = pk2(v0[0] * bflo(gb.x), v0[1] * bfhi(gb.x)); w.y = pk2(v0[2] * bflo(gb.y), v0[3] * bfhi(gb.y));
                w.z = pk2(v1[0] * bflo(gb.z), v1[1] * bfhi(gb.z)); w.w = pk2(v1[2] * bflo(gb.w), v1[3] * bfhi(gb.w));
                *(u32x4*)(out + row * DM + colb + 128 * bj) = w;
            }
            __builtin_amdgcn_sched_barrier(0);
        }
    }
};


struct EpiProj {
    static constexpr bool PERM = true, AFTER_DRAIN = false, MIDK = false;
    Epi<EP_PROJ> base; bf16* la; float* fixl; float* taill; const float* mu; LAS float* X;
    static __device__ __forceinline__ f32x4 act4(f32x4 f, int cgrp) {
        const float k = cgrp == 0 ? 2.0f : 1.0f, sc = cgrp == 0 ? 2.0f : 1.0f, of = cgrp == 0 ? -1.0f : 0.0f;
        f32x4 y;
#pragma unroll
        for (int i = 0; i < 4; ++i) { const float sg = __builtin_amdgcn_rcpf(1.0f + __expf(-k * f[i])); const float v = fmaf(sc, sg, of); y[i] = cgrp == 1 ? f[i] : v; }
        return y;
    }
    __device__ __forceinline__ void operator()(const f32x4 (&acc)[2][2][4][2], const pg8::Unit& u, int wr, int wc, int fr, int fq) const {
        if (u.pn != 6) { base(acc, u, wr, wc, fr, fq); return; }
        asm volatile("" : "+v"(fr), "+v"(fq));
        if (fr == 15) {
#pragma unroll
            for (int ai = 0; ai < 2; ++ai)
#pragma unroll
                for (int bj = 0; bj < 2; ++bj) { LAS float* x = X + (ai * 2 + wr) * 256 + bj * 128 + wc * 32 + 8 * fq; *(LAS f32x4*)x = acc[ai][bj][3][0]; *(LAS f32x4*)(x + 4) = acc[ai][bj][3][1]; }
        }
        asm volatile("s_waitcnt lgkmcnt(0)\n\ts_barrier" ::: "memory");
        const bool seq_start = (u.pm & 7) == 0;
#pragma unroll
        for (int bj = 0; bj < 2; ++bj) {
            const int chl = bj * 128 + wc * 32 + 8 * fq, cgrp = chl >> 6;
            const f32x4 m0 = *(const f32x4*)(mu + 1536 + chl), m1 = *(const f32x4*)(mu + 1536 + chl + 4);
#pragma unroll
            for (int ai = 0; ai < 2; ++ai) {
                const int grp = ai * 2 + wr;
                f32x4 p1a = (f32x4){0.f, 0.f, 0.f, 0.f}, p1b = p1a;
                if (grp > 0) { const LAS float* x = X + (grp - 1) * 256 + chl; p1a = *(const LAS f32x4*)x; p1b = *(const LAS f32x4*)(x + 4); }
#pragma unroll
                for (int m = 0; m < 4; ++m) {
                    const f32x4 ca = acc[ai][bj][m][0], cb = acc[ai][bj][m][1];
                    const f32x4 c1a = EpiUp::rot<0x121>(ca), c1b = EpiUp::rot<0x121>(cb);
                    const f32x4 pa = EpiUp::sel(fr >= 1, c1a, p1a), pb = EpiUp::sel(fr >= 1, c1b, p1b);
                    const f32x4 fa = ca + (pa - ca) * m0, fb = cb + (pb - cb) * m1;
                    const int rl = ai * 128 + wr * 64 + m * 16 + fr;
                    if (grp == 0 && m == 0 && fr == 0 && !seq_start) {
                        float* fx = fixl + (size_t)u.pm * 256 + chl; *(f32x4*)fx = ca; *(f32x4*)(fx + 4) = cb;
                    } else {
                        const f32x4 ya = act4(fa, cgrp), yb = act4(fb, cgrp);
                        u32x4 w; w.x = pk2(ya.x, ya.y); w.y = pk2(ya.z, ya.w); w.z = pk2(yb.x, yb.y); w.w = pk2(yb.z, yb.w);
                        *(u32x4*)(la + ((size_t)u.pm * 256 + rl) * 256 + chl) = w;
                    }
                    p1a = c1a; p1b = c1b;
                    __builtin_amdgcn_sched_barrier(0);
                }
            }
            if (wr == 1 && fr == 15) { float* tx = taill + (size_t)u.pm * 256 + chl; *(f32x4*)tx = acc[1][bj][3][0]; *(f32x4*)(tx + 4) = acc[1][bj][3][1]; }
        }
    }
};

template <int REMAP_UP = 0> __device__ __forceinline__ void p0_transpose_item(const float* W, int K, int N, bf16* WT, LAS float* scr, int item, int lane, int ldo = 0, int koff = 0) {
    if (ldo == 0) ldo = K;
    const int nblk = N / 32, kb = item / nblk, nb = item % nblk, k0 = 64 * kb, n0 = 32 * nb;
    int r0 = n0;
    if constexpr (REMAP_UP == 1) r0 = n0 < DFF ? 256 * (n0 / 128) + (n0 % 128) : 256 * ((n0 - DFF) / 128) + 128 + ((n0 - DFF) % 128);
    if constexpr (REMAP_UP == 2) { if (n0 >= 2560) { const int j = n0 - 2560; r0 = j < 1024 ? 2560 + 256 * (j / 128) + (j % 128) : 2560 + 256 * ((j - 1024) / 128) + 128 + ((j - 1024) % 128); } }
    float wv[32];
#pragma unroll
    for (int i = 0; i < 32; ++i) { const int kk = 2 * i + (lane >> 5); wv[i] = W[(size_t)(k0 + kk) * N + n0 + (lane & 31)]; }
#pragma unroll
    for (int i = 0; i < 32; ++i) { const int kk = 2 * i + (lane >> 5); scr[kk * 33 + (lane & 31)] = wv[i]; }
    asm volatile("s_waitcnt lgkmcnt(0)" ::: "memory");
    const int c = lane & 7;
#pragma unroll
    for (int j = 0; j < 4; ++j) { const int n = (lane >> 3) + 8 * j; const LAS float* s = scr + (8 * c) * 33 + n;
        const float wsc = (REMAP_UP == 2 && n0 >= 2560) ? -1.4426950408889634f : (REMAP_UP == 1 && n0 >= DFF) ? -0.6931471805599453f : 1.0f;
        u32x4 o; o.x = pk2(s[0 * 33] * wsc, s[1 * 33] * wsc); o.y = pk2(s[2 * 33] * wsc, s[3 * 33] * wsc); o.z = pk2(s[4 * 33] * wsc, s[5 * 33] * wsc); o.w = pk2(s[6 * 33] * wsc, s[7 * 33] * wsc);
        *(u32x4*)(WT + (size_t)(r0 + n) * ldo + koff + k0 + 8 * c) = o; }
    asm volatile("s_waitcnt lgkmcnt(0)" ::: "memory");
}

__device__ __forceinline__ void norm_mod_rows(const float* src, const float* gain, const float* mod, int shoff, int scoff, bf16* dst, int gw, int ngw, int lane) {
    constexpr int SPAN = 16;
    for (int m0 = gw * SPAN; m0 < M; m0 += ngw * SPAN) {
        const int b = m0 >> 11;
        f32x4 gs[4], sh[4];
#pragma unroll
        for (int j = 0; j < 4; ++j) {
            const f32x4 g = ((const f32x4*)gain)[64 * j + lane];
            const f32x4 sc = ((const f32x4*)(mod + b * 6144 + scoff))[64 * j + lane];
            sh[j] = ((const f32x4*)(mod + b * 6144 + shoff))[64 * j + lane];
            gs[j] = g * (sc + 1.0f);
        }
        f32x4 v[4], nv[4];
        { const f32x4* xr = (const f32x4*)(src + (size_t)m0 * DM) + lane;
#pragma unroll
          for (int j = 0; j < 4; ++j) v[j] = xr[64 * j]; }
#pragma unroll 1
        for (int i = 0; i < SPAN; ++i) {
            const int m = m0 + i;
            if (i + 1 < SPAN) { const f32x4* xr = (const f32x4*)(src + (size_t)(m + 1) * DM) + lane;
#pragma unroll
                for (int j = 0; j < 4; ++j) nv[j] = xr[64 * j]; }
            float s = 0.f;
#pragma unroll
            for (int j = 0; j < 4; ++j) s += (v[j].x * v[j].x + v[j].y * v[j].y) + (v[j].z * v[j].z + v[j].w * v[j].w);
            const float rstd = rsqrtf(wave_sum(s) * (1.f / DM) + 1e-6f);
            u32x2* o8 = (u32x2*)(dst + (size_t)m * DM) + lane;
#pragma unroll
            for (int j = 0; j < 4; ++j) {
                const f32x4 o = (v[j] * rstd) * gs[j] + sh[j];
                u32x2 w; w.x = pk2(o.x, o.y); w.y = pk2(o.z, o.w); o8[64 * j] = w;
            }
#pragma unroll
            for (int j = 0; j < 4; ++j) v[j] = nv[j];
        }
    }
}

constexpr int KPITCH = 72, VPITCH = 260;
__device__ __forceinline__ void attn_phase(LAS unsigned char* lds, const bf16* PQKV, bf16* Y2, const float* sinks, int bid, int G, int tid) {
    const int lane = tid & 63, wid = tid >> 6, r32 = lane & 31, hi = lane >> 5;
    LAS bf16* Kl = (LAS bf16*)lds;
    LAS bf16* Vt = (LAS bf16*)(lds + 256 * KPITCH * 2);
    for (int unit = bid; unit < NB * 16 * 2; unit += G) {
        const int kvh = unit & 1, blk = (unit >> 1) & 15, b = unit >> 5;
        __syncthreads();
        {
            const int key = tid >> 1, half = tid & 1;
            const int tpos = blk * 128 - 128 + key;
            u32x4 kv[4], vv[4];
            if (tpos >= 0) {
                const bf16* src = PQKV + (size_t)(b * SEQ + tpos) * ATTN_COLS + 512 + kvh * 64 + half * 32;
#pragma unroll
                for (int i = 0; i < 4; ++i) { kv[i] = *(const u32x4*)(src + 8 * i); vv[i] = *(const u32x4*)(src + 128 + 8 * i); }
            } else {
#pragma unroll
                for (int i = 0; i < 4; ++i) { kv[i] = (u32x4){0u, 0u, 0u, 0u}; vv[i] = (u32x4){0u, 0u, 0u, 0u}; }
            }
#pragma unroll
            for (int i = 0; i < 4; ++i) *(LAS u32x4*)(Kl + key * KPITCH + half * 32 + 8 * i) = kv[i];
#pragma unroll
            for (int i = 0; i < 4; ++i) {
                const int d0 = half * 32 + 8 * i;
                Vt[(d0 + 0) * VPITCH + key] = (bf16)(vv[i].x & 0xffffu); Vt[(d0 + 1) * VPITCH + key] = (bf16)(vv[i].x >> 16);
                Vt[(d0 + 2) * VPITCH + key] = (bf16)(vv[i].y & 0xffffu); Vt[(d0 + 3) * VPITCH + key] = (bf16)(vv[i].y >> 16);
                Vt[(d0 + 4) * VPITCH + key] = (bf16)(vv[i].z & 0xffffu); Vt[(d0 + 5) * VPITCH + key] = (bf16)(vv[i].z >> 16);
                Vt[(d0 + 6) * VPITCH + key] = (bf16)(vv[i].w & 0xffffu); Vt[(d0 + 7) * VPITCH + key] = (bf16)(vv[i].w >> 16);
            }
        }
        __syncthreads();
        for (int si = wid; si < 16; si += 8) {
            const int g = si >> 2, j = si & 3, head = kvh * 4 + g;
            const int tok = b * SEQ + blk * 128 + 32 * j + r32;
            bf16x8 qf[4];
#pragma unroll
            for (int d0 = 0; d0 < 4; ++d0) qf[d0] = *(const bf16x8*)(PQKV + (size_t)tok * ATTN_COLS + head * 64 + 16 * d0 + 8 * hi);
            f32x16 s[5];
#pragma unroll
            for (int kt = 0; kt < 5; ++kt) {
                s[kt] = (f32x16){0.f, 0.f, 0.f, 0.f, 0.f, 0.f, 0.f, 0.f, 0.f, 0.f, 0.f, 0.f, 0.f, 0.f, 0.f, 0.f};
#pragma unroll
                for (int d0 = 0; d0 < 4; ++d0) {
                    const bf16x8 kf = *(const LAS bf16x8*)(Kl + (32 * (j + kt) + r32) * KPITCH + 16 * d0 + 8 * hi);
                    s[kt] = __builtin_amdgcn_mfma_f32_32x32x16_bf16(kf, qf[d0], s[kt], 0, 0, 0);
                }
                __builtin_amdgcn_sched_barrier(0);
            }
            constexpr float L2E = 1.4426950408889634f;
            const float sl2 = exp2f(-(float)(head + 1)) * L2E, sink2 = sinks[head] * L2E;
            float mx = sink2;
            int dbase = r32 + 128 - 4 * hi; asm volatile("" : "+v"(dbase));
            const float bias = -sl2 * (float)dbase;
#pragma unroll
            for (int kt = 0; kt < 5; ++kt)
#pragma unroll
                for (int i = 0; i < 16; ++i) {
                    const int off = 32 * kt + (i & 3) + 8 * (i >> 2);
                    float v = fmaf(s[kt][i], 0.125f * L2E, fmaf(sl2, (float)off, bias));
                    bool valid = true;
                    if (kt == 0) valid = dbase - off < 128;
                    if (kt == 4) valid = dbase - off >= 0;
                    if (blk == 0 && j + kt < 4) valid = false;
                    v = valid ? v : -INFINITY;
                    s[kt][i] = v; mx = fmaxf(mx, v);
                }
            mx = fmaxf(mx, __shfl_xor(mx, 32));
            float sum = 0.f;
#pragma unroll
            for (int kt = 0; kt < 5; ++kt)
#pragma unroll
                for (int i = 0; i < 16; ++i) { const float p = __builtin_amdgcn_exp2f(s[kt][i] - mx); s[kt][i] = p; sum += p; }
            sum += __shfl_xor(sum, 32);
            const float inv = __builtin_amdgcn_rcpf(sum + __builtin_amdgcn_exp2f(sink2 - mx));
            f32x16 o[2];
            o[0] = (f32x16){0.f, 0.f, 0.f, 0.f, 0.f, 0.f, 0.f, 0.f, 0.f, 0.f, 0.f, 0.f, 0.f, 0.f, 0.f, 0.f}; o[1] = o[0];
#pragma unroll
            for (int kt = 0; kt < 5; ++kt)
#pragma unroll
                for (int st = 0; st < 2; ++st) {
                    u32x4 pw;
                    pw.x = pk2(s[kt][8 * st + 0] * inv, s[kt][8 * st + 1] * inv); pw.y = pk2(s[kt][8 * st + 2] * inv, s[kt][8 * st + 3] * inv);
                    pw.z = pk2(s[kt][8 * st + 4] * inv, s[kt][8 * st + 5] * inv); pw.w = pk2(s[kt][8 * st + 6] * inv, s[kt][8 * st + 7] * inv);
                    const bf16x8 pf = __builtin_bit_cast(bf16x8, pw);
#pragma unroll
                    for (int dt = 0; dt < 2; ++dt) {
                        const LAS bf16* vp = Vt + (32 * dt + r32) * VPITCH + 32 * (j + kt) + 16 * st + 4 * hi;
                        const u32x2 lo = *(const LAS u32x2*)vp, hh = *(const LAS u32x2*)(vp + 8);
                        const u32x4 vw = (u32x4){lo.x, lo.y, hh.x, hh.y};
                        o[dt] = __builtin_amdgcn_mfma_f32_32x32x16_bf16(__builtin_bit_cast(bf16x8, vw), pf, o[dt], 0, 0, 0);
                    }
                    __builtin_amdgcn_sched_barrier(0);
                }
            bf16* op = Y2 + (size_t)tok * DM + 512 + head * 64;
#pragma unroll
            for (int dt = 0; dt < 2; ++dt)
#pragma unroll
                for (int q4 = 0; q4 < 4; ++q4) {
                    u32x2 w; w.x = pk2(o[dt][4 * q4 + 0], o[dt][4 * q4 + 1]); w.y = pk2(o[dt][4 * q4 + 2], o[dt][4 * q4 + 3]);
                    *(u32x2*)(op + 32 * dt + 8 * q4 + 4 * hi) = w;
                }
        }
    }
}

constexpr int SC_T = 32, SC_STEP = 320, SC_VOFF = SC_T * SC_STEP, SC_BUF = SC_VOFF + 32 * SC_T;
struct ScanRegs { u32x2 r0, k0, v0, r1, k1, v1, as; f32x4 dec; };
__device__ __forceinline__ void scan_load(ScanRegs& R, const bf16* PR, const float* DEC, const bf16* ASIG, int b, int h, int t, int cg4) {
    const size_t row = (size_t)b * SEQ + t;
    const bf16* p = PR + row * RWKV_COLS + h * 64 + cg4;
    R.r0 = *(const u32x2*)p; R.k0 = *(const u32x2*)(p + 512); R.v0 = *(const u32x2*)(p + 1024);
    if (t > 0) { const bf16* q = p - RWKV_COLS; R.r1 = *(const u32x2*)q; R.k1 = *(const u32x2*)(q + 512); R.v1 = *(const u32x2*)(q + 1024); }
    else { R.r1 = (u32x2){0u, 0u}; R.k1 = R.r1; R.v1 = R.r1; }
    R.dec = *(const f32x4*)(DEC + row * RW + h * 64 + cg4);
    R.as = *(const u32x2*)(ASIG + row * RW + h * 64 + cg4);
}
__device__ __forceinline__ f32x4 unpack4(u32x2 w) { return (f32x4){bflo(w.x), bfhi(w.x), bflo(w.y), bfhi(w.y)}; }
__device__ __forceinline__ f32x4 lerp4(u32x2 cur, u32x2 prev, f32x4 mu) { const f32x4 c = unpack4(cur), p = unpack4(prev); return c + (p - c) * mu; }

__device__ __forceinline__ void scan_convert(const ScanRegs& R, LAS float* cbuf, int ls, int cg4, int half, size_t trow, int h, f32x4 mur, f32x4 muk, f32x4 muv, f32x4 kkw, f32x4 kaw, f32x4 rkw,
                                             float* BONP, bf16* FVP) {
    LAS float* d = cbuf + ls * SC_STEP + cg4;
    const f32x4 fr = lerp4(R.r0, R.r1, mur), fk = lerp4(R.k0, R.k1, muk), fv = lerp4(R.v0, R.v1, muv), as = unpack4(R.as);
    const f32x4 kr = fk * kkw;
    const float ss = sum16((kr.x * kr.x + kr.y * kr.y) + (kr.z * kr.z + kr.w * kr.w));
    const float inv = __builtin_amdgcn_rsqf(fmaxf(ss, 1e-24f));
    const f32x4 kk = kr * inv;
    *(LAS f32x4*)(d) = fr;
    *(LAS f32x4*)(d + 64) = R.dec;
    const f32x4 kp = fk * ((as - 1.0f) * kaw + 1.0f);
    *(LAS f32x4*)(d + 128) = kp;
    { const f32x4 q = fr * kp * rkw; const float bon = sum16((q.x + q.y) + (q.z + q.w));
      if (half == 0 && cg4 == 0) BONP[trow * 8 + h] = bon;
      if (half == 0) { u32x2 w; w.x = pk2(fv.x, fv.y); w.y = pk2(fv.z, fv.w); *(u32x2*)(FVP + trow * RW + h * 64 + cg4) = w; } }
    *(LAS f32x4*)(d + 192) = -kk;
    *(LAS f32x4*)(d + 256) = kk * as;
    if ((cg4 >> 5) == half) { LAS float* vb = cbuf + SC_VOFF + (cg4 & 31) * SC_T + ls; vb[0] = fv.x; vb[SC_T] = fv.y; vb[2 * SC_T] = fv.z; vb[3 * SC_T] = fv.w; }
}

__device__ __forceinline__ float rscatter16(const float (&p)[16], bool b3, bool b2, bool b1, bool b0) {
    float q[8], r[4], t[2];
#pragma unroll
    for (int i = 0; i < 8; ++i) { const float keep = b3 ? p[8 + i] : p[i], send = b3 ? p[i] : p[8 + i]; q[i] = keep + dppf<0x128>(send); }
#pragma unroll
    for (int i = 0; i < 4; ++i) { const float keep = b2 ? q[4 + i] : q[i], send = b2 ? q[i] : q[4 + i]; r[i] = keep + dppf<0x141>(send); }
#pragma unroll
    for (int i = 0; i < 2; ++i) { const float keep = b1 ? r[2 + i] : r[i], send = b1 ? r[i] : r[2 + i]; t[i] = keep + dppf<0x4E>(send); }
    const float keep = b0 ? t[1] : t[0], send = b0 ? t[0] : t[1];
    return keep + dppf<0xB1>(send);
}

__device__ __forceinline__ void scan_phase(LAS unsigned char* lds, const bf16* PR_, const float* DEC_, const bf16* ASIG_, bf16* Y,
                                           const float* mu, const float* k_k, const float* k_a, const float* r_k, float* BONP, bf16* FVP, int bid, int G, int tid) {
    LAS float* buf = (LAS float*)lds;
    const int lane = tid & 63, wid = tid >> 6;
    const bool loader = wid >= 4;
    const int ls = (tid & 255) >> 4, cg4 = (tid & 15) * 4;
    const int kg = lane & 15, rA = 4 * (wid & 3) + (lane >> 4), kg4 = kg * 4;
    for (int item = bid; item < NB * 16; item += G) {
        const int half = item & 1, h = (item >> 1) & 7, b = item >> 4;
        const int c0 = h * 64 + cg4;
        const f32x4 mur = *(const f32x4*)(mu + c0), muk = *(const f32x4*)(mu + 512 + c0), muv = *(const f32x4*)(mu + 1024 + c0);
        const f32x4 kkw = *(const f32x4*)(k_k + c0), kaw = *(const f32x4*)(k_a + c0), rkw = *(const f32x4*)(r_k + c0);
        bf16* yp = Y + ((size_t)b * SEQ + kg) * RW + h * 64 + half * 32 + rA;
        ScanRegs R0, R1, R2, R3;
        f32x2 SA01 = (f32x2){0.f, 0.f}, SA23 = SA01, SB01 = SA01, SB23 = SA01;
        if (loader) {
            scan_load(R0, PR_, DEC_, ASIG_, b, h, ls, cg4); scan_load(R1, PR_, DEC_, ASIG_, b, h, ls + 16, cg4);
            scan_load(R2, PR_, DEC_, ASIG_, b, h, SC_T + ls, cg4); scan_load(R3, PR_, DEC_, ASIG_, b, h, SC_T + ls + 16, cg4);
            const size_t trow = (size_t)b * SEQ + ls;
            scan_convert(R0, buf, ls, cg4, half, trow, h, mur, muk, muv, kkw, kaw, rkw, BONP, FVP);
            scan_convert(R1, buf, ls + 16, cg4, half, trow + 16, h, mur, muk, muv, kkw, kaw, rkw, BONP, FVP);
            scan_convert(R2, buf + SC_BUF, ls, cg4, half, trow + SC_T, h, mur, muk, muv, kkw, kaw, rkw, BONP, FVP);
            scan_convert(R3, buf + SC_BUF, ls + 16, cg4, half, trow + SC_T + 16, h, mur, muk, muv, kkw, kaw, rkw, BONP, FVP);
            scan_load(R0, PR_, DEC_, ASIG_, b, h, 2 * SC_T + ls, cg4); scan_load(R1, PR_, DEC_, ASIG_, b, h, 2 * SC_T + ls + 16, cg4);
        }
        __syncthreads();
#define SC_LDB(B_, R4, W4, K4, A4, B4, st) do { const LAS float* sb_ = (B_) + (st) * SC_STEP; R4 = *(const LAS f32x4*)(sb_ + kg4); W4 = *(const LAS f32x4*)(sb_ + 64 + kg4); \
    K4 = *(const LAS f32x4*)(sb_ + 128 + kg4); A4 = *(const LAS f32x4*)(sb_ + 192 + kg4); B4 = *(const LAS f32x4*)(sb_ + 256 + kg4); } while (0)
#define LO2(q) __builtin_shufflevector(q, q, 0, 1)
#define HI2(q) __builtin_shufflevector(q, q, 2, 3)
        f32x4 r4, w4, k4, a4, b4, nr, nw, nk, na, nb, vA4, nvA4, vB4, nvB4;
        float psaA = 0.f, psaB = 0.f;
        if (wid < 4) {
            SC_LDB(buf, r4, w4, k4, a4, b4, 0);
            SC_LDB(buf, nr, nw, nk, na, nb, 1);
            const LAS float* vr0 = buf + SC_VOFF + rA * SC_T;
            vA4 = *(const LAS f32x4*)vr0; nvA4 = *(const LAS f32x4*)(vr0 + 4); vB4 = *(const LAS f32x4*)(vr0 + 16 * SC_T); nvB4 = *(const LAS f32x4*)(vr0 + 16 * SC_T + 4);
            const f32x2 tA = SA01 * LO2(a4) + SA23 * HI2(a4), tB = SB01 * LO2(a4) + SB23 * HI2(a4); psaA = tA.x + tA.y; psaB = tB.x + tB.y;
        }
        int slot = 0;
        for (int c = 0; c < SEQ / SC_T; ++c) {
            const int slot1 = slot == 2 ? 0 : slot + 1, slot2 = slot1 == 2 ? 0 : slot1 + 1;
            if (loader && c + 2 < SEQ / SC_T) {
                LAS float* cbuf = buf + slot2 * SC_BUF;
                const size_t trow = (size_t)b * SEQ + (c + 2) * SC_T + ls;
                scan_convert(R0, cbuf, ls, cg4, half, trow, h, mur, muk, muv, kkw, kaw, rkw, BONP, FVP);
                scan_convert(R1, cbuf, ls + 16, cg4, half, trow + 16, h, mur, muk, muv, kkw, kaw, rkw, BONP, FVP);
                if (c + 3 < SEQ / SC_T) { scan_load(R0, PR_, DEC_, ASIG_, b, h, (c + 3) * SC_T + ls, cg4); scan_load(R1, PR_, DEC_, ASIG_, b, h, (c + 3) * SC_T + ls + 16, cg4); }
            }
            if (wid < 4) {
            const LAS float* cb = buf + slot * SC_BUF; const LAS float* nbuf = buf + slot1 * SC_BUF;
            const LAS float* vrA = cb + SC_VOFF + rA * SC_T; const LAS float* vrB = vrA + 16 * SC_T;
            const LAS float* nvrA = nbuf + SC_VOFF + rA * SC_T; const LAS float* nvrB = nvrA + 16 * SC_T;
            float PA[16], PB[16];
#pragma unroll
            for (int s = 0; s < SC_T; ++s) {
                f32x4 mr, mw, mk, ma, mb;
                if (s + 2 < SC_T) SC_LDB(cb, mr, mw, mk, ma, mb, s + 2); else SC_LDB(nbuf, mr, mw, mk, ma, mb, s + 2 - SC_T);
                const float vA = vA4[s & 3], vB = vB4[s & 3];
                const f32x2 mA01 = SA01 * LO2(w4) + LO2(k4) * vA, mA23 = SA23 * HI2(w4) + HI2(k4) * vA;
                const f32x2 mB01 = SB01 * LO2(w4) + LO2(k4) * vB, mB23 = SB23 * HI2(w4) + HI2(k4) * vB;
                psaA += dppf<0xB1>(psaA); psaB += dppf<0xB1>(psaB);
                psaA += dppf<0x4E>(psaA); psaB += dppf<0x4E>(psaB);
                psaA += dppf<0x141>(psaA); psaB += dppf<0x141>(psaB);
                psaA += dppf<0x128>(psaA); psaB += dppf<0x128>(psaB);
                SA01 = LO2(b4) * psaA + mA01; SA23 = HI2(b4) * psaA + mA23;
                SB01 = LO2(b4) * psaB + mB01; SB23 = HI2(b4) * psaB + mB23;
                { const f32x2 uA = SA01 * LO2(r4) + SA23 * HI2(r4), uB = SB01 * LO2(r4) + SB23 * HI2(r4); PA[s & 15] = uA.x + uA.y; PB[s & 15] = uB.x + uB.y; }
                if ((s & 15) == 15) {
                    const float yA = rscatter16(PA, (kg & 8) != 0, (kg & 4) != 0, (kg & 2) != 0, (kg & 1) != 0), yB = rscatter16(PB, (kg & 8) != 0, (kg & 4) != 0, (kg & 2) != 0, (kg & 1) != 0);
                    { const unsigned pw = pk2(yA, yB); yp[(size_t)(c * SC_T + (s - 15)) * RW] = (bf16)(pw & 0xffffu); yp[(size_t)(c * SC_T + (s - 15)) * RW + 16] = (bf16)(pw >> 16); }
                }
                { const f32x2 uA = SA01 * LO2(na) + SA23 * HI2(na), uB = SB01 * LO2(na) + SB23 * HI2(na); psaA = uA.x + uA.y; psaB = uB.x + uB.y; }
                r4 = nr; w4 = nw; k4 = nk; a4 = na; b4 = nb;
                nr = mr; nw = mw; nk = mk; na = ma; nb = mb;
                if ((s & 3) == 3) { vA4 = nvA4; vB4 = nvB4;
                    if (s + 5 < SC_T) { nvA4 = *(const LAS f32x4*)(vrA + s + 5); nvB4 = *(const LAS f32x4*)(vrB + s + 5); }
                    else { nvA4 = *(const LAS f32x4*)(nvrA + s + 5 - SC_T); nvB4 = *(const LAS f32x4*)(nvrB + s + 5 - SC_T); } }
            }
            }
            __syncthreads();
            slot = slot1;
        }
#undef SC_LDB
#undef LO2
#undef HI2
        __syncthreads();
    }
}

#define XB_TMO      128
#define XB_XCNT(j)  (256  + 64 * (j))
#define XB_XSUB(j)  (1280 + 64 * (j))
#define XB_XGEN(j)  (2304 + 64 * (j))
#define XB_TOP      3328
#define XB_TOPGEN   3392
#define XCD_BAR_WORDS 3456
#define XB_SPIN_CAP (1u << 18)

__device__ __forceinline__ unsigned xb_ld(unsigned* p)              { return __hip_atomic_load(p, __ATOMIC_RELAXED, __HIP_MEMORY_SCOPE_AGENT); }
__device__ __forceinline__ unsigned xb_add(unsigned* p, unsigned v) { return __hip_atomic_fetch_add(p, v, __ATOMIC_RELAXED, __HIP_MEMORY_SCOPE_AGENT); }
__device__ __forceinline__ unsigned xb_xcc_id() { return (unsigned)__builtin_amdgcn_s_getreg((3 << 11) | 20) & 0xFu; }
#define XB_SPIN(cond, bar) do { unsigned _sp = 0; while (cond) { __builtin_amdgcn_s_sleep(1); \
    if ((++_sp & 255u) == 0u) { if (xb_ld(&(bar)[XB_TMO])) break; if (_sp > XB_SPIN_CAP) { atomicAdd(&(bar)[XB_TMO], 1u); break; } } } } while (0)

struct XcdBarrier {
    unsigned* bar; unsigned x;
    volatile LAS unsigned* st;
};

__device__ __forceinline__ XcdBarrier xcd_barrier_post(unsigned* bar, volatile LAS unsigned* st) {
    XcdBarrier b; b.bar = bar; b.x = xb_xcc_id(); b.st = st;
    if (threadIdx.x == 0) (void)xb_add(&bar[XB_XCNT(b.x)], 1u);
    return b;
}
__device__ __forceinline__ void xcd_barrier_complete(unsigned* bar, unsigned x, unsigned& nloc, unsigned& nx) {
    const unsigned G = gridDim.x * gridDim.y * gridDim.z;
    unsigned sum, cnt, mine, sp = 0u;
    for (;;) {
        sum = 0u; cnt = 0u; mine = 0u;
#pragma unroll
        for (unsigned j = 0; j < 16; ++j) { const unsigned c = xb_ld(&bar[XB_XCNT(j)]); sum += c; cnt += (c > 0u) ? 1u : 0u; mine = (j == x) ? c : mine; }
        if (sum == G) break;
        __builtin_amdgcn_s_sleep(1);
        if ((++sp & 255u) == 0u) { if (xb_ld(&bar[XB_TMO])) break; if (sp > XB_SPIN_CAP) { atomicAdd(&bar[XB_TMO], 1u); break; } }
    }
    nloc = mine > 0u ? mine : 1u; nx = cnt > 0u ? cnt : 1u;
}

__device__ __forceinline__ void xcd_barrier(const XcdBarrier& b) {
    asm volatile("s_waitcnt vmcnt(0)" ::: "memory");
    __syncthreads();
    if (threadIdx.x == 0) {
        unsigned* bar = b.bar;
        __builtin_amdgcn_s_waitcnt(0);
        unsigned nloc = b.st[0], nx = b.st[1];
        if (nloc == 0u) { xcd_barrier_complete(bar, b.x, nloc, nx); b.st[0] = nloc; b.st[1] = nx; }
        const unsigned old = xb_add(&bar[XB_XSUB(b.x)], 1u);
        const unsigned gen = old / nloc;
        if (old + 1u == (gen + 1u) * nloc) {
            __builtin_amdgcn_fence(__ATOMIC_RELEASE, "agent");
            asm volatile("s_waitcnt vmcnt(0)" ::: "memory");
            const unsigned og = xb_add(&bar[XB_TOP], 1u);
            const unsigned tg = og / nx;
            if (og + 1u == (tg + 1u) * nx) xb_add(&bar[XB_TOPGEN], 1u);
            else XB_SPIN(xb_ld(&bar[XB_TOPGEN]) == tg, bar);
            __builtin_amdgcn_fence(__ATOMIC_ACQUIRE, "agent");
            xb_add(&bar[XB_XGEN(b.x)], 1u);
            asm volatile("s_waitcnt vmcnt(0)" ::: "memory");
        } else {
            XB_SPIN(xb_ld(&bar[XB_XGEN(b.x)]) == gen, bar);
            __builtin_amdgcn_fence(__ATOMIC_ACQUIRE, "agent");
            asm volatile("s_waitcnt vmcnt(0)" ::: "memory");
        }
    }
    __syncthreads();
}

struct Args { const float* in[27]; float* out; unsigned char* ws; int ph_lo, ph_hi; };
enum { I_X = 0, I_C, I_ADAW, I_ADAB, I_N1G, I_WIN, I_MU, I_W0, I_WUP, I_A0, I_AUP, I_GUP, I_KK, I_KA, I_RK, I_GNW, I_GNB, I_SINKS, I_WBA, I_WBB, I_WOUT, I_N2G,
       I_FUP, I_CONVW, I_CONVB, I_FDN, I_FING };
constexpr int LDS_BYTES = 147456;
constexpr int N_PHASES = 14;

__global__ void __launch_bounds__(NTHR, 2) fwd_kernel(Args a) {
    extern __shared__ __attribute__((aligned(16))) unsigned char lds_raw[];
    LAS unsigned char* lds = (LAS unsigned char*)lds_raw;
    cg::grid_group grid = cg::this_grid();
    volatile LAS unsigned* MISC = (volatile LAS unsigned*)(lds + 147456 - 64);
    if (threadIdx.x < 16) MISC[threadIdx.x] = 0u;
    __syncthreads();
    const XcdBarrier xbar = xcd_barrier_post((unsigned*)(a.ws + WS_CTL), MISC);
    const int G = gridDim.x, bid = blockIdx.x, NGW = G * NWAVES, GT = G * NTHR;
#define PHASE_IDS int tid = threadIdx.x; asm volatile("" : "+v"(tid)); const int lane = tid & 63, wave = __builtin_amdgcn_readfirstlane(tid >> 6); \
    const int gw = bid * NWAVES + wave, gtid = bid * NTHR + tid; (void)lane; (void)gw; (void)gtid;
typedef __attribute__((address_space(1))) unsigned char* GASP;
#define WSL unsigned long long wsl_ = (unsigned long long)a.ws; asm volatile("" : "+s"(wsl_)); const GASP wsl = (GASP)wsl_;
#define MOD ((float*)(__attribute__((address_space(1))) float*)(wsl + WS_MOD))
#define WIN_T ((bf16*)(__attribute__((address_space(1))) bf16*)(wsl + WS_WIN))
#define WLORA_T ((bf16*)(__attribute__((address_space(1))) bf16*)(wsl + WS_WLORA))
#define WA_T ((bf16*)(__attribute__((address_space(1))) bf16*)(wsl + WS_WA))
#define WB_T ((bf16*)(__attribute__((address_space(1))) bf16*)(wsl + WS_WB))
#define WOUT_T ((bf16*)(__attribute__((address_space(1))) bf16*)(wsl + WS_WOUT))
#define WUP_T ((bf16*)(__attribute__((address_space(1))) bf16*)(wsl + WS_WUP))
#define WDN_T ((bf16*)(__attribute__((address_space(1))) bf16*)(wsl + WS_WDN))
#define U ((bf16*)(__attribute__((address_space(1))) bf16*)(wsl + WS_U))
#define Y2 U
#define PG ((bf16*)(__attribute__((address_space(1))) bf16*)(wsl + WS_PG))
#define PR ((bf16*)(__attribute__((address_space(1))) bf16*)(wsl + WS_PR))
#define MERGED PR
#define PQKV ((bf16*)(__attribute__((address_space(1))) bf16*)(wsl + WS_PQKV))
#define GB ((bf16*)(__attribute__((address_space(1))) bf16*)(wsl + WS_G))
#define FIXL ((float*)(__attribute__((address_space(1))) float*)(wsl + WS_FIXL))
#define TAILL ((float*)(__attribute__((address_space(1))) float*)(wsl + WS_TAILL))
#define LA ((bf16*)(__attribute__((address_space(1))) bf16*)(wsl + WS_LA))
#define TMP ((bf16*)(__attribute__((address_space(1))) bf16*)(wsl + WS_TMP))
#define ASIG ((bf16*)(__attribute__((address_space(1))) bf16*)(wsl + WS_ASIG))
#define ACT ((bf16*)(__attribute__((address_space(1))) bf16*)(wsl + WS_ACT))
#define FIXG ((float*)(__attribute__((address_space(1))) float*)(wsl + WS_FIXG))
#define FIXV ((float*)(__attribute__((address_space(1))) float*)(wsl + WS_FIXV))
#define TAILG ((float*)(__attribute__((address_space(1))) float*)(wsl + WS_TAILG))
#define SLOT1 ((float*)(__attribute__((address_space(1))) float*)(wsl + WS_SLOT1))
#define SLOT2 ((float*)(__attribute__((address_space(1))) float*)(wsl + WS_SLOT2))
#define CNT1 ((unsigned*)(__attribute__((address_space(1))) unsigned*)(wsl + WS_CTL + 32768))
#define CNT2 ((unsigned*)(__attribute__((address_space(1))) unsigned*)(wsl + WS_CTL + 65536))
#define BON ((float*)(__attribute__((address_space(1))) float*)(wsl + WS_LA))
#define H1B ((bf16*)(__attribute__((address_space(1))) bf16*)(wsl + WS_H1B))
#define FV PQKV
#define DEC (a.out)
#define YS ((bf16*)(a.out + (size_t)M * RW))
    const int lo = a.ph_lo < 0 ? 0 : a.ph_lo, hi = a.ph_hi;
    const bool cg_seams = a.ph_lo < 0;
#ifndef ONLY
#define ONLY -1
#endif
#define IN(k) ((ONLY < 0 || ONLY == (k)) && lo <= (k) && (k) < hi)
#define SEAM(k) do { if (IN(k) && IN((k) + 1)) { if (cg_seams) grid.sync(); else xcd_barrier(xbar); } } while (0)

    if (IN(0)) { WSL
        PHASE_IDS
        LAS float* scr = (LAS float*)(lds + wave * 16384);
        constexpr int I_IN = 16 * 144, I_A = 8 * 32, I_O = 16 * 32, I_UP = 16 * 176, I_DN = 44 * 32;
        constexpr int NITEMS = I_IN + 2 * I_A + I_O + I_UP + I_DN;
        for (int it = gw; it < NITEMS; it += NGW) {
            int r = it;
            if (r < I_IN) { p0_transpose_item<2>(a.in[I_WIN], 1024, IN_COLS, WIN_T, scr, r, lane); continue; } r -= I_IN;
            if (r < I_A) { p0_transpose_item(a.in[I_WBA], 512, 1024, WA_T, scr, r, lane, 1024, 0); continue; } r -= I_A;
            if (r < I_A) { p0_transpose_item(a.in[I_WBB], 512, 1024, WA_T, scr, r, lane, 1024, 512); continue; } r -= I_A;
            if (r < I_O) { p0_transpose_item(a.in[I_WOUT], 1024, 1024, WOUT_T, scr, r, lane); continue; } r -= I_O;
            if (r < I_UP) { p0_transpose_item<1>(a.in[I_FUP], 1024, 2 * DFF, WUP_T, scr, r, lane); continue; } r -= I_UP;
            p0_transpose_item(a.in[I_FDN], DFF, 1024, WDN_T, scr, r, lane);
        }
        for (int idx = gtid; idx < 1536 * 256; idx += GT) {
            const int n = idx >> 8, k = idx & 255; float v = 0.f;
            if (n < 512) { if (k < 64) v = a.in[I_WUP][k * 512 + n]; }
            else if (n < 1024) { if (k >= 64 && k < 128) v = a.in[I_AUP][(k - 64) * 512 + (n - 512)]; }
            else { if (k >= 128) v = a.in[I_GUP][(k - 128) * 512 + (n - 1024)]; }
            WLORA_T[idx] = (bf16)(pk2(v, 0.f) & 0xffffu);
        }
        __syncthreads();
        if (bid < 96) {
            LAS float* cact = (LAS float*)lds;
            LAS float* part = (LAS float*)(lds + 65536);
            for (int i = tid; i < NB * DM; i += NTHR) { const int b = i >> 10, k = i & 1023; const float c = a.in[I_C][i]; cact[k * 16 + b] = c / (1.0f + __expf(-c)); }
            __syncthreads();
            const int col = 64 * bid + lane;
            float acc[16];
#pragma unroll
            for (int b = 0; b < 16; ++b) acc[b] = 0.f;
            for (int k = 128 * wave; k < 128 * wave + 128; ++k) {
                const float wv = a.in[I_ADAW][(size_t)k * 6144 + col];
                const LAS f32x4* cp = (const LAS f32x4*)(cact + k * 16);
#pragma unroll
                for (int q = 0; q < 4; ++q) { const f32x4 cv = cp[q]; acc[4 * q] += cv.x * wv; acc[4 * q + 1] += cv.y * wv; acc[4 * q + 2] += cv.z * wv; acc[4 * q + 3] += cv.w * wv; }
            }
#pragma unroll
            for (int b = 0; b < 16; ++b) part[(wave * 16 + b) * 64 + lane] = acc[b];
            __syncthreads();
            for (int i = tid; i < 16 * 64; i += NTHR) {
                const int b = i >> 6, l = i & 63; float s = a.in[I_ADAB][64 * bid + l];
#pragma unroll
                for (int w = 0; w < 8; ++w) s += part[(w * 16 + b) * 64 + l];
                MOD[b * 6144 + 64 * bid + l] = s;
            }
        }
    }
    SEAM(0);
    if (IN(1)) { WSL PHASE_IDS norm_mod_rows(a.in[I_X], a.in[I_N1G], MOD, 0, 1024, U, gw, NGW, lane); }
    SEAM(1);
    if (IN(2)) { WSL
        pg8::Gemm g{U, WIN_T, M, IN_COLS, DM, DM}; pg8::StaticOrder S; S.init(M, IN_COLS, G, bid);
        EpiProj E{Epi<EP_PROJ>{PR, PQKV, PG, nullptr, nullptr, nullptr, nullptr, nullptr}, LA, FIXL, TAILL, a.in[I_MU], (LAS float*)(lds + 131072)};
        pg8::gemm_phase<EpiProj, pg8::StaticOrder, true>(lds, g, S, E);
    }
    SEAM(2);
    if (IN(4)) { WSL PHASE_IDS
        pg8::Gemm g{LA, WLORA_T, M, 1536, 256, 256}; pg8::StaticOrder S; S.init(M, 1536, G, bid);
        {
            const float* mu = a.in[I_MU];
            pg8::Unit fu;
            for (int i = 0; S.next(i, fu); ++i) {
                const int pm = fu.pm;
                if ((pm & 7) == 0 || tid >= 64) continue;
                const int chl = 4 * tid;
                const f32x4 cur = *(const f32x4*)(FIXL + (size_t)pm * 256 + chl), prv = *(const f32x4*)(TAILL + (size_t)(pm - 1) * 256 + chl);
                const f32x4 f = cur + (prv - cur) * (*(const f32x4*)(mu + 1536 + chl));
                const f32x4 y = EpiProj::act4(f, chl >> 6);
                u32x2 w; w.x = pk2(y.x, y.y); w.y = pk2(y.z, y.w);
                *(u32x2*)(LA + (size_t)pm * 256 * 256 + chl) = w;
            }
            asm volatile("s_waitcnt vmcnt(0)" ::: "memory");
            __syncthreads();
        }
        Epi<EP_LORA> E{ASIG, GB, nullptr, DEC, a.in[I_W0], a.in[I_A0], nullptr, nullptr};
        pg8::gemm_phase<Epi<EP_LORA>, pg8::StaticOrder, true>(lds, g, S, E);
        attn_phase(lds, PQKV, Y2, a.in[I_SINKS], bid, G, tid);
    }
    SEAM(4);
    if (IN(5)) { WSL PHASE_IDS scan_phase(lds, PR, DEC, ASIG, YS, a.in[I_MU], a.in[I_KK], a.in[I_KA], a.in[I_RK], BON, FV, bid, G, tid); }
    SEAM(5);
    if (IN(6)) { WSL
        PHASE_IDS
        const float* mu = a.in[I_MU];
#pragma unroll 2
        for (int idx = gtid; idx < M * 128; idx += GT) {
            const int row = idx >> 7, h = (idx >> 4) & 7, c = h * 64 + (idx & 15) * 4;
            const f32x4 y4 = unpack4(*(const u32x2*)(YS + (size_t)row * RW + c));
            const float mean = sum16((y4.x + y4.y) + (y4.z + y4.w)) * (1.0f / 64.0f);
            const f32x4 d = y4 - mean;
            const float var = sum16((d.x * d.x + d.y * d.y) + (d.z * d.z + d.w * d.w)) * (1.0f / 64.0f);
            const float rs = rsqrtf(var + 64e-5f);
            const f32x4 yn = d * rs * (*(const f32x4*)(a.in[I_GNW] + c)) + (*(const f32x4*)(a.in[I_GNB] + c));
            const f32x4 fv = unpack4(*(const u32x2*)(FV + (size_t)row * RW + c));
            const float bonus = BON[(size_t)row * 8 + h];
            const f32x4 g = unpack4(*(const u32x2*)(GB + (size_t)row * RW + c));
            const f32x4 o = (yn + fv * bonus) * g;
            u32x2 w; w.x = pk2(o.x, o.y); w.y = pk2(o.z, o.w);
            *(u32x2*)(Y2 + (size_t)row * DM + c) = w;
        }
    }
    SEAM(6);
    if (IN(7)) { WSL
        pg8::Gemm g{Y2, WA_T, M, DM, DM, DM}; pg8::StaticOrder S; S.init(M, DM, G, bid);
        EpiBranch E{MERGED, PG};
        pg8::gemm_phase<EpiBranch, pg8::StaticOrder, true>(lds, g, S, E);
    }
    SEAM(7);
    if (IN(8)) { WSL
        pg8::Gemm g{MERGED, WOUT_T, M, DM, DM, DM}; pg8::StaticOrder S; S.init(M, DM, G, bid);
        EpiNorm<false> E{a.in[I_X], nullptr, U, MOD, a.in[I_N2G], SLOT1, CNT1, (LAS float*)(lds + 131072), H1B};
        pg8::gemm_phase<EpiNorm<false>, pg8::StaticOrder, true>(lds, g, S, E);
    }
    SEAM(8);
    if (IN(10)) { WSL
        pg8::Gemm g{U, WUP_T, M, 2 * DFF, DM, DM}; pg8::StaticOrder S; S.init(M, 2 * DFF, G, bid);
        EpiUp E{ACT, FIXG, FIXV, TAILG, a.in[I_CONVW], a.in[I_CONVB], (LAS float*)(lds + 131072)};
        pg8::gemm_phase<EpiUp, pg8::StaticOrder, true>(lds, g, S, E);
    }
    SEAM(10);
    if (IN(11)) { WSL
        PHASE_IDS
        const float* cw = a.in[I_CONVW]; const float* cb = a.in[I_CONVB];
        for (int idx = gtid; idx < 128 * 2 * (DFF / 4); idx += GT) {
            const int pm = idx / (2 * (DFF / 4)), rem = idx - pm * (2 * (DFF / 4)), rr = rem / (DFF / 4), ch = (rem - rr * (DFF / 4)) * 4;
            if ((pm & 7) == 0) continue;
            const f32x4 t0 = *(const f32x4*)(TAILG + (size_t)((pm - 1) * 2) * DFF + ch), t1 = *(const f32x4*)(TAILG + (size_t)((pm - 1) * 2 + 1) * DFF + ch);
            const f32x4 f0 = *(const f32x4*)(FIXG + (size_t)(pm * 2) * DFF + ch), f1 = *(const f32x4*)(FIXG + (size_t)(pm * 2 + 1) * DFF + ch);
            const f32x4 vv = *(const f32x4*)(FIXV + (size_t)(pm * 2 + rr) * DFF + ch);
            const f32x4 g2 = rr ? t1 : t0, g1 = rr ? f0 : t1, g0 = rr ? f1 : f0;
            const f32x4 z = (*(const f32x4*)(cw + ch)) * g2 + (*(const f32x4*)(cw + DFF + ch)) * g1 + (*(const f32x4*)(cw + 2 * DFF + ch)) * g0 + (*(const f32x4*)(cb + ch));
            const f32x4 o = EpiUp::siluv(z) * vv * -1.4426950408889634f;
            u32x2 w; w.x = pk2(o.x, o.y); w.y = pk2(o.z, o.w);
            *(u32x2*)(ACT + (size_t)(pm * 256 + rr) * DFF + ch) = w;
        }
    }
    SEAM(11);
    if (IN(12)) { WSL
        pg8::Gemm g{ACT, WDN_T, M, DM, DFF, DFF}; pg8::StaticOrder S; S.init(M, DM, G, bid);
        EpiNorm<true> E{nullptr, a.out, nullptr, MOD, a.in[I_FING], SLOT2, CNT2, (LAS float*)(lds + 131072), H1B};
        pg8::gemm_phase<EpiNorm<true>, pg8::StaticOrder, true>(lds, g, S, E);
    }
#undef IN
#undef SEAM
}

extern "C" void kernel_launch(void* const* d_in, const int* in_sizes, int n_in, void* d_out, int out_size, void* d_ws, size_t ws_size, hipStream_t stream) {
    static int grid = 0;
    if (grid == 0) {
        if (n_in != 27 || out_size != M * DM || ws_size < WS_END) { fprintf(stderr, "kernel_launch: unexpected shapes: n_in %d out %d ws %zu (need %zu)\n", n_in, out_size, ws_size, (size_t)WS_END); grid = -1; return; }
        int dev = 0, cus = 0, per_cu = 0;
        (void)hipGetDevice(&dev);
        (void)hipDeviceGetAttribute(&cus, hipDeviceAttributeMultiprocessorCount, dev);
        if (hipFuncSetAttribute((const void*)fwd_kernel, hipFuncAttributeMaxDynamicSharedMemorySize, LDS_BYTES) != hipSuccess) { fprintf(stderr, "kernel_launch: hipFuncSetAttribute failed\n"); grid = -1; return; }
        if (hipOccupancyMaxActiveBlocksPerMultiprocessor(&per_cu, (const void*)fwd_kernel, NTHR, LDS_BYTES) != hipSuccess || per_cu < 1) { fprintf(stderr, "kernel_launch: occupancy query failed (%d)\n", per_cu); (void)hipGetLastError(); per_cu = 1; }
        grid = cus * per_cu; if (grid > 256) grid = 256;
        fprintf(stderr, "kernel_launch: cus %d per_cu %d grid %d\n", cus, per_cu, grid);
    }
    if (grid < 0) return;
    if (hipMemsetAsync((char*)d_ws + WS_CTL, 0, CTL_BYTES, stream) != hipSuccess) { fprintf(stderr, "kernel_launch: memset failed\n"); return; }
    Args a{};
    for (int i = 0; i < 27; ++i) a.in[i] = (const float*)d_in[i];
    a.out = (float*)d_out; a.ws = (unsigned char*)d_ws;
    a.ph_lo = 0; a.ph_hi = N_PHASES;
    void* args[] = {&a};
    hipError_t e = hipLaunchCooperativeKernel((const void*)fwd_kernel, dim3(grid), dim3(NTHR), args, LDS_BYTES, stream);
    if (e != hipSuccess) fprintf(stderr, "cooperative launch failed: %s (grid %d)\n", hipGetErrorString(e), grid);
}
```

```cpp
#include <hip/hip_runtime.h>
#include <hip/hip_cooperative_groups.h>
#include <cstdio>
#include <cstdint>
namespace cg = cooperative_groups;
namespace pg8 {
#define PG8_LAS __attribute__((address_space(3)))
typedef unsigned short bf16_t;
typedef short bf16x8 __attribute__((ext_vector_type(8)));
typedef float f32x4 __attribute__((ext_vector_type(4)));
typedef unsigned u32x4 __attribute__((ext_vector_type(4)));
constexpr int BM = 256, BK = 64, HALF = 128, HTB = HALF * BK * 2  , STAGE_BYTES = 8 * HTB, NXCD = 8, WGM = 8;

__host__ __device__ __forceinline__ int lds_byte(int r, int c) { const int st = (r >> 4) * 2 + (c >> 5), rr = r & 15, cc = c & 31, ob = rr * 64 + cc * 2; return st * 1024 + (ob ^ (((ob >> 9) & 1) << 5)); }
__host__ __device__ __forceinline__ void stage_rc(int b, int& R, int& C) { const int st = b / 1024, sb = b % 1024, swz = sb ^ (((sb >> 9) & 1) << 5); R = (st >> 1) * 16 + swz / 64; C = (st & 1) * 32 + (swz % 64) / 2; }
__host__ __device__ __forceinline__ int perm32(int rho) { const int n = rho >> 4, i = rho & 15; return 8 * (i >> 2) + 4 * n + (i & 3); }

struct Unit { int pm, pn; };
struct Gemm { const bf16_t* A; const bf16_t* Bt; int M, N, K, lda; };

struct StaticOrder {
    int nM, nN, nwg, G, c;
    __host__ __device__ void init(int M, int N, int G_, int c_) { nM = M / BM; nN = N / BM; nwg = nM * nN; G = G_; c = c_; }
    __host__ __device__ bool next(int i, Unit& u) const {
        const long L = (long)i * G + c; if (L >= nwg) return false;
        int wgid = (int)L; { const int q = nwg / NXCD, r = nwg % NXCD, xcd = wgid % NXCD, off = wgid / NXCD; wgid = (xcd < r ? xcd * (q + 1) : r * (q + 1) + (xcd - r) * q) + off; }
        const int nig = WGM * nN, gid = wgid / nig, fm = gid * WGM, gsz = (nM - fm) < WGM ? (nM - fm) : WGM;
        u.pm = fm + ((wgid % nig) % gsz); u.pn = (wgid % nig) / gsz; return true;
    }
    __device__ __forceinline__ void a_ready(const Unit&) const {}
    __device__ __forceinline__ void done(const Unit&) const {}
};


__device__ __forceinline__ unsigned cvt_pk_bf16(float lo, float hi) { unsigned r; asm volatile("v_cvt_pk_bf16_f32 %0, %1, %2" : "=v"(r) : "v"(lo), "v"(hi)); return r; }
template <class Epi, class Sched, bool ALIGN_EPI = false>
__device__ __forceinline__ void gemm_phase(PG8_LAS unsigned char* lds, const Gemm g, const Sched& S, const Epi& E) {
    const int tid = threadIdx.x, wid = __builtin_amdgcn_readfirstlane(tid >> 6), lane = tid & 63, wr = wid >> 2, wc = wid & 3, fr = lane & 15, fq = lane >> 4;
    const int K = g.K, nt = K / BK;
    unsigned voffA[2], voffB[2];
#pragma unroll
    for (int i = 0; i < 2; ++i) { int R, C; stage_rc(tid * 16 + i * 8192, R, C); const int Rb = Epi::PERM ? ((R & ~31) + perm32(R & 31)) : R;
        voffA[i] = (unsigned)(R * g.lda + C) * 2u; voffB[i] = (unsigned)(Rb * K + C) * 2u; }
    const size_t kstep = (size_t)(BK * 2);
    const size_t hstepA = (size_t)HALF * g.lda * 2, hstepB = (size_t)HALF * K * 2;
    const size_t tstepA = 2 * hstepA, tstepB = 2 * hstepB;
    const unsigned ldsw = (unsigned)wid * 1024u;
    const int aoff = lds_byte(wr * 64 + fr, fq * 8), boff = lds_byte(wc * 32 + fr, fq * 8);
#define PG8_SA(b, h) (((b) * 2 + (h)) * HTB)
#define PG8_SB(b, h) ((4 + (b) * 2 + (h)) * HTB)
#define PG8_STAGE(bufoff, gbase, voff) do { _Pragma("unroll") for (int _i = 0; _i < 2; ++_i) \
        __builtin_amdgcn_global_load_lds((const unsigned*)((const char*)(gbase) + (voff)[_i]), (PG8_LAS unsigned*)(lds + (bufoff) + ldsw + _i * 8192), 16, 0, 0); } while (0)
#define PG8_LDA(dst, b, h) do { _Pragma("unroll") for (int m = 0; m < 4; ++m) _Pragma("unroll") for (int k = 0; k < 2; ++k) dst[m][k] = *(const PG8_LAS bf16x8*)(lds + PG8_SA(b, h) + aoff + m * 2048 + k * 1024); } while (0)
#define PG8_LDB(dst, b, h) do { _Pragma("unroll") for (int n = 0; n < 2; ++n) _Pragma("unroll") for (int k = 0; k < 2; ++k) dst[n][k] = *(const PG8_LAS bf16x8*)(lds + PG8_SB(b, h) + boff + n * 2048 + k * 1024); } while (0)
#define PG8_MMA(ai, bj, At, Bt) do { __builtin_amdgcn_s_setprio(1); _Pragma("unroll") for (int m = 0; m < 4; ++m) _Pragma("unroll") for (int n = 0; n < 2; ++n) _Pragma("unroll") for (int k = 0; k < 2; ++k) \
        acc[ai][bj][m][n] = __builtin_amdgcn_mfma_f32_16x16x32_bf16(Bt[n][k], At[m][k], acc[ai][bj][m][n], 0, 0, 0); __builtin_amdgcn_s_setprio(0); } while (0)
#define PG8_WAIT_V(n) asm volatile("s_waitcnt vmcnt(" #n ")" ::: "memory")
#define PG8_WAIT_L(n) asm volatile("s_waitcnt lgkmcnt(" #n ")" ::: "memory")
#define PG8_BAR __builtin_amdgcn_s_barrier()
#define PG8_SCHED __builtin_amdgcn_sched_barrier(0)
    Unit cur, nxt; int ui = 0;
    if (!S.next(0, cur)) return;
    f32x4 acc[2][2][4][2];
#pragma unroll
    for (int a = 0; a < 2; ++a)
#pragma unroll
        for (int b = 0; b < 2; ++b)
#pragma unroll
            for (int m = 0; m < 4; ++m)
#pragma unroll
                for (int n = 0; n < 2; ++n) acc[a][b][m][n] = (f32x4){0.f, 0.f, 0.f, 0.f};
    bf16x8 At[4][2], B0[2][2], B1[2][2];
    const char* cA = (const char*)g.A + (size_t)cur.pm * tstepA; const char* cB = (const char*)g.Bt + (size_t)cur.pn * tstepB;
    S.a_ready(cur);
    {
        PG8_STAGE(PG8_SB(0, 0), cB, voffB); PG8_STAGE(PG8_SB(0, 1), cB + hstepB, voffB); PG8_STAGE(PG8_SA(0, 0), cA, voffA); PG8_STAGE(PG8_SA(0, 1), cA + hstepA, voffA);
        if (wr == 1) PG8_BAR;
        PG8_WAIT_V(2); PG8_BAR;
        PG8_STAGE(PG8_SB(1, 0), cB + kstep, voffB); PG8_STAGE(PG8_SA(1, 0), cA + kstep, voffA); PG8_STAGE(PG8_SB(1, 1), cB + hstepB + kstep, voffB);
        PG8_WAIT_V(6); PG8_BAR;
    }
    for (;;) {
        const bool has_next = S.next(ui + 1, nxt);
        const char* nA = has_next ? (const char*)g.A + (size_t)nxt.pm * tstepA : cA; const char* nB = has_next ? (const char*)g.Bt + (size_t)nxt.pn * tstepB : cB;
        for (int t = 0; t < nt; t += 2) {
            if constexpr (Epi::MIDK) { if (t == (nt >> 1)) E.mid(acc, cur, wr, wc, fr, fq); }
            const bool last = (t == nt - 2);
            const char* a1 = cA + (size_t)(t + 1) * kstep;
            const char* a2 = last ? nA : cA + (size_t)(t + 2) * kstep; const char* b2 = last ? nB : cB + (size_t)(t + 2) * kstep;
            const char* a3 = a2 + kstep; const char* b3 = b2 + kstep;
            if (last && has_next) S.a_ready(nxt);
            {
            PG8_LDB(B0, 0, 0); PG8_LDB(B1, 0, 1); PG8_SCHED; PG8_LDA(At, 0, 0); PG8_STAGE(PG8_SA(1, 1), a1 + hstepA, voffA);
            PG8_WAIT_V(8); PG8_WAIT_L(0); PG8_BAR; PG8_MMA(0, 0, At, B0); PG8_MMA(0, 1, At, B1); PG8_BAR; PG8_SCHED;
            PG8_LDA(At, 0, 1); PG8_STAGE(PG8_SB(0, 0), b2, voffB); PG8_STAGE(PG8_SB(0, 1), b2 + hstepB, voffB); PG8_STAGE(PG8_SA(0, 0), a2, voffA);
            PG8_WAIT_V(8); PG8_WAIT_L(0); PG8_BAR; PG8_MMA(1, 0, At, B0); PG8_MMA(1, 1, At, B1); PG8_BAR; PG8_SCHED;
            PG8_LDB(B0, 1, 0); PG8_LDB(B1, 1, 1); PG8_SCHED; PG8_LDA(At, 1, 0); PG8_STAGE(PG8_SA(0, 1), a2 + hstepA, voffA);
            PG8_WAIT_V(8); PG8_WAIT_L(0); PG8_BAR; PG8_MMA(0, 0, At, B0); PG8_MMA(0, 1, At, B1); PG8_BAR; PG8_SCHED;
            PG8_LDA(At, 1, 1); PG8_STAGE(PG8_SB(1, 0), b3, voffB); PG8_STAGE(PG8_SB(1, 1), b3 + hstepB, voffB); PG8_STAGE(PG8_SA(1, 0), a3, voffA);
            PG8_WAIT_V(8); PG8_WAIT_L(0); PG8_BAR; PG8_MMA(1, 0, At, B0); PG8_MMA(1, 1, At, B1); PG8_BAR; PG8_SCHED;
            }
        }
        if constexpr (ALIGN_EPI) { if (wr == 0) PG8_BAR; }
        if constexpr (!Epi::AFTER_DRAIN) { E(acc, cur, wr, wc, fr, fq); S.done(cur); }
        if (!has_next) break;
#pragma unroll
        for (int a = 0; a < 2; ++a)
#pragma unroll
            for (int b = 0; b < 2; ++b)
#pragma unroll
                for (int m = 0; m < 4; ++m)
#pragma unroll
                    for (int n = 0; n < 2; ++n) acc[a][b][m][n] = (f32x4){0.f, 0.f, 0.f, 0.f};
        cur = nxt; cA = nA; cB = nB; ++ui;
        if constexpr (ALIGN_EPI) { if (wr == 1) PG8_BAR; }
    }
    PG8_WAIT_V(0);
    if constexpr (!ALIGN_EPI) { if (wr == 0) PG8_BAR; }
    PG8_BAR;
    if constexpr (Epi::AFTER_DRAIN) { E.fused(acc, cur, wr, wc, fr, fq, lds, wid, lane); S.done(cur); }
#undef PG8_SA
#undef PG8_SB
#undef PG8_STAGE
#undef PG8_LDA
#undef PG8_LDB
#undef PG8_MMA
#undef PG8_WAIT_V
#undef PG8_WAIT_L
#undef PG8_BAR
#undef PG8_SCHED
}
}

constexpr int DM = 1024, NB = 16, SEQ = 2048, M = NB * SEQ;
constexpr int RW = 512, RWKV_COLS = 1792, ATTN_COLS = 768, IN_COLS = 4608, DFF = 2816;
constexpr int NWAVES = 8, NTHR = 512;
constexpr size_t MiB = 1u << 20;
constexpr size_t WS_MOD = 0;
constexpr size_t WS_CTL = 512 * 1024, CTL_BYTES = 131072;
constexpr size_t WS_FIXL = 408 * MiB, WS_TAILL = 409 * MiB;
constexpr size_t WS_G = 410 * MiB;
constexpr size_t WS_H1B = 330 * MiB;
constexpr size_t WS_SLOT1 = 316 * MiB, WS_SLOT2 = 318 * MiB;
constexpr size_t WS_WIN = 1 * MiB;
constexpr size_t WS_WLORA = 10 * MiB;
constexpr size_t WS_WA = 11 * MiB;
constexpr size_t WS_WB = 12 * MiB;
constexpr size_t WS_WOUT = 13 * MiB;
constexpr size_t WS_WUP = 15 * MiB;
constexpr size_t WS_WDN = 26 * MiB;
constexpr size_t WS_U = 40 * MiB;
constexpr size_t WS_PG = 104 * MiB;
constexpr size_t WS_PR = 232 * MiB;
constexpr size_t WS_PQKV = 344 * MiB;
constexpr size_t WS_LA = 392 * MiB;
constexpr size_t WS_TMP = 408 * MiB;
constexpr size_t WS_ASIG = 472 * MiB;
constexpr size_t WS_ACT = 104 * MiB;
constexpr size_t WS_FIXG = 300 * MiB, WS_FIXV = 304 * MiB, WS_TAILG = 308 * MiB;
constexpr size_t WS_END = 504 * MiB;

#define LAS __attribute__((address_space(3)))
typedef unsigned short bf16;
typedef float f32x4 __attribute__((ext_vector_type(4)));
typedef float f32x2 __attribute__((ext_vector_type(2)));
typedef float f32x16 __attribute__((ext_vector_type(16)));
typedef unsigned u32x4 __attribute__((ext_vector_type(4)));
typedef unsigned u32x2 __attribute__((ext_vector_type(2)));
typedef short bf16x8 __attribute__((ext_vector_type(8)));
typedef short s16x4 __attribute__((ext_vector_type(4)));

__device__ __forceinline__ float bflo(unsigned w) { return __uint_as_float(w << 16); }
__device__ __forceinline__ float bfhi(unsigned w) { return __uint_as_float(w & 0xffff0000u); }
typedef float f32x2c_t __attribute__((ext_vector_type(2))); typedef __bf16 bf16x2c_t __attribute__((ext_vector_type(2)));
__device__ __forceinline__ unsigned pk2(float lo, float hi) { const f32x2c_t v = {lo, hi}; const bf16x2c_t b = __builtin_convertvector(v, bf16x2c_t); return __builtin_bit_cast(unsigned, b); }
__device__ __forceinline__ float sigmoidf_(float x) { return 1.0f / (1.0f + __expf(-x)); }
__device__ __forceinline__ float sigmoid_fast(float x) { return __builtin_amdgcn_rcpf(1.0f + __expf(-x)); }
__device__ __forceinline__ float wave_sum(float v) {
#pragma unroll
    for (int o = 1; o < 64; o <<= 1) v += __shfl_xor(v, o);
    return v;
}
template <int CTRL> __device__ __forceinline__ float dppf(float x) { return __builtin_bit_cast(float, __builtin_amdgcn_mov_dpp(__builtin_bit_cast(int, x), CTRL, 0xf, 0xf, true)); }
__device__ __forceinline__ float sum16(float x) { x += dppf<0xB1>(x); x += dppf<0x4E>(x); x += dppf<0x141>(x); x += dppf<0x128>(x); return x; }

enum { EP_PROJ = 0, EP_LORA = 1, EP_BA = 2, EP_BB = 3, EP_WO = 4, EP_UP = 5, EP_DOWN = 6 };
template <int MODE> struct Epi {
    static constexpr bool PERM = true, AFTER_DRAIN = false, MIDK = false;
    bf16* o0; bf16* o1; bf16* o2; float* of; const float* p0; const float* p1; const bf16* q0; const float* mod;
    __device__ __forceinline__ void operator()(const f32x4 (&acc)[2][2][4][2], const pg8::Unit& u, int wr, int wc, int fr, int fq) const {
        asm volatile("" : "+v"(fr), "+v"(fq));
#pragma unroll
        for (int ai = 0; ai < 2; ++ai)
#pragma unroll
            for (int m = 0; m < 4; ++m) {
                const int row = u.pm * 256 + ai * 128 + wr * 64 + m * 16 + fr;
#pragma unroll
                for (int bj = 0; bj < 2; ++bj) {
                    const int col = u.pn * 256 + bj * 128 + wc * 32 + 8 * fq;
                    f32x4 v0 = acc[ai][bj][m][0], v1 = acc[ai][bj][m][1];
                    if constexpr (MODE == EP_PROJ) {
                        bf16* dst;
                        if (u.pn < 7) dst = o0 + (size_t)row * RWKV_COLS + col;
                        else if (u.pn < 10) dst = o1 + (size_t)row * ATTN_COLS + (col - RWKV_COLS);
                        else {
                            if (bj == 0) continue;
                            const int jq = 128 * (u.pn - 10) + wc * 32 + 8 * fq;
                            const f32x4 a0 = acc[ai][0][m][0], a1 = acc[ai][0][m][1];
                            f32x4 r0v, r1v;
#pragma unroll
                            for (int i = 0; i < 4; ++i) {
                                const float ea0 = 1.0f + __builtin_amdgcn_exp2f(a0[i]), eb0 = 1.0f + __builtin_amdgcn_exp2f(v0[i]), ea1 = 1.0f + __builtin_amdgcn_exp2f(a1[i]), eb1 = 1.0f + __builtin_amdgcn_exp2f(v1[i]);
                                r0v[i] = eb0 * __builtin_amdgcn_rcpf(ea0); r1v[i] = eb1 * __builtin_amdgcn_rcpf(ea1);
                                v0[i] = __builtin_amdgcn_rcpf(eb0); v1[i] = __builtin_amdgcn_rcpf(eb1);
                            }
                            u32x4 wr_; wr_.x = pk2(r0v[0], r0v[1]); wr_.y = pk2(r0v[2], r0v[3]); wr_.z = pk2(r1v[0], r1v[1]); wr_.w = pk2(r1v[2], r1v[3]);
                            *(u32x4*)(o2 + (size_t)row * 2048 + jq) = wr_;
                            dst = o2 + (size_t)row * 2048 + 1024 + jq;
                        }
                        u32x4 w; w.x = pk2(v0[0], v0[1]); w.y = pk2(v0[2], v0[3]); w.z = pk2(v1[0], v1[1]); w.w = pk2(v1[2], v1[3]);
                        *(u32x4*)dst = w;
                    } else if constexpr (MODE == EP_LORA) {
                        if (u.pn < 2) {
                            const f32x4 b0 = *(const f32x4*)(p0 + col), b1 = *(const f32x4*)(p0 + col + 4);
                            f32x4 r0, r1;
#pragma unroll
                            for (int i = 0; i < 4; ++i) {
                                r0[i] = __builtin_amdgcn_exp2f(-0.87503877f * sigmoid_fast(b0[i] + v0[i]));
                                r1[i] = __builtin_amdgcn_exp2f(-0.87503877f * sigmoid_fast(b1[i] + v1[i]));
                            }
                            float* d = of + (size_t)row * RW + col; *(f32x4*)d = r0; *(f32x4*)(d + 4) = r1;
                        } else if (u.pn < 4) {
                            const int c = col - 512;
                            const f32x4 b0 = *(const f32x4*)(p1 + c), b1 = *(const f32x4*)(p1 + c + 4);
#pragma unroll
                            for (int i = 0; i < 4; ++i) { v0[i] = sigmoid_fast(v0[i] + b0[i]); v1[i] = sigmoid_fast(v1[i] + b1[i]); }
                            u32x4 w; w.x = pk2(v0[0], v0[1]); w.y = pk2(v0[2], v0[3]); w.z = pk2(v1[0], v1[1]); w.w = pk2(v1[2], v1[3]);
                            *(u32x4*)(o0 + (size_t)row * RW + c) = w;
                        } else {
                            const int c = col - 1024;
                            u32x4 w; w.x = pk2(v0[0], v0[1]); w.y = pk2(v0[2], v0[3]); w.z = pk2(v1[0], v1[1]); w.w = pk2(v1[2], v1[3]);
                            *(u32x4*)(o1 + (size_t)row * RW + c) = w;
                        }
                    } else if constexpr (MODE == EP_BA || MODE == EP_BB) {
                        const u32x4 gt = *(const u32x4*)(q0 + (size_t)row * 2048 + (MODE == EP_BB ? 1024 : 0) + col);
                        v0[0] *= bflo(gt.x); v0[1] *= bfhi(gt.x); v0[2] *= bflo(gt.y); v0[3] *= bfhi(gt.y);
                        v1[0] *= bflo(gt.z); v1[1] *= bfhi(gt.z); v1[2] *= bflo(gt.w); v1[3] *= bfhi(gt.w);
                        if constexpr (MODE == EP_BB) {
                            const u32x4 t = *(const u32x4*)(o1 + (size_t)row * DM + col);
                            v0[0] += bflo(t.x); v0[1] += bfhi(t.x); v0[2] += bflo(t.y); v0[3] += bfhi(t.y);
                            v1[0] += bflo(t.z); v1[1] += bfhi(t.z); v1[2] += bflo(t.w); v1[3] += bfhi(t.w);
                        }
                        u32x4 w; w.x = pk2(v0[0], v0[1]); w.y = pk2(v0[2], v0[3]); w.z = pk2(v1[0], v1[1]); w.w = pk2(v1[2], v1[3]);
                        *(u32x4*)(o0 + (size_t)row * DM + col) = w;
                    } else if constexpr (MODE == EP_WO || MODE == EP_DOWN) {
                        const int b = row >> 11;
                        const float* gp = mod + b * 6144 + (MODE == EP_WO ? 2048 : 5120) + col;
                        const f32x4 g0 = *(const f32x4*)gp, g1 = *(const f32x4*)(gp + 4);
                        const float* xp = p0 + (size_t)row * DM + col;
                        const f32x4 x0 = *(const f32x4*)xp, x1 = *(const f32x4*)(xp + 4);
                        float* d = of + (size_t)row * DM + col;
                        *(f32x4*)d = x0 + g0 * v0; *(f32x4*)(d + 4) = x1 + g1 * v1;
                    } else if constexpr (MODE == EP_UP) {
                        u32x4 w; w.x = pk2(v0[0], v0[1]); w.y = pk2(v0[2], v0[3]); w.z = pk2(v1[0], v1[1]); w.w = pk2(v1[2], v1[3]);
                        *(u32x4*)(o0 + (size_t)row * (2 * DFF) + col) = w;
                    }
                    __builtin_amdgcn_sched_barrier(0);
                }
            }
    }
};


struct EpiUp {
    static constexpr bool PERM = true, AFTER_DRAIN = false, MIDK = false;
    bf16* act; float* fixg; float* fixv; float* tailg; const float* cw; const float* cb; LAS float* X;
    template <int CTRL> static __device__ __forceinline__ f32x4 rot(f32x4 v) { return (f32x4){dppf<CTRL>(v.x), dppf<CTRL>(v.y), dppf<CTRL>(v.z), dppf<CTRL>(v.w)}; }
    static __device__ __forceinline__ f32x4 sel(bool c, f32x4 a, f32x4 b) { return (f32x4){c ? a.x : b.x, c ? a.y : b.y, c ? a.z : b.z, c ? a.w : b.w}; }
    static __device__ __forceinline__ f32x4 siluv(f32x4 z) { return (f32x4){z.x * sigmoid_fast(z.x), z.y * sigmoid_fast(z.y), z.z * sigmoid_fast(z.z), z.w * sigmoid_fast(z.w)}; }
    __device__ __forceinline__ void operator()(const f32x4 (&acc)[2][2][4][2], const pg8::Unit& u, int wr, int wc, int fr, int fq) const {
        asm volatile("" : "+v"(fr), "+v"(fq));
        const int chl = wc * 32 + 8 * fq, ch = u.pn * 128 + chl;
        if (fr >= 14) {
#pragma unroll
            for (int ai = 0; ai < 2; ++ai) { LAS float* x = X + ((ai * 2 + wr) * 2 + (fr - 14)) * 128 + chl; *(LAS f32x4*)x = acc[ai][0][3][0]; *(LAS f32x4*)(x + 4) = acc[ai][0][3][1]; }
        }
        asm volatile("s_waitcnt lgkmcnt(0)\n\ts_barrier" ::: "memory");
        const f32x4 w0a = *(const f32x4*)(cw + ch), w0b = *(const f32x4*)(cw + ch + 4), w1a = *(const f32x4*)(cw + DFF + ch), w1b = *(const f32x4*)(cw + DFF + ch + 4);
        const f32x4 w2a = *(const f32x4*)(cw + 2 * DFF + ch), w2b = *(const f32x4*)(cw + 2 * DFF + ch + 4), ba = *(const f32x4*)(cb + ch), bb = *(const f32x4*)(cb + ch + 4);
        const bool seq_start = (u.pm & 7) == 0;
#pragma unroll
        for (int ai = 0; ai < 2; ++ai) {
            const int grp = ai * 2 + wr;
            f32x4 p1a = (f32x4){0.f, 0.f, 0.f, 0.f}, p1b = p1a, p2a = p1a, p2b = p1a;
            if (grp > 0) {
                const LAS float* x = X + ((grp - 1) * 2) * 128 + chl;
                const f32x4 x14a = *(const LAS f32x4*)x, x14b = *(const LAS f32x4*)(x + 4), x15a = *(const LAS f32x4*)(x + 128), x15b = *(const LAS f32x4*)(x + 132);
                p1a = x15a; p1b = x15b; p2a = sel(fr == 0, x14a, x15a); p2b = sel(fr == 0, x14b, x15b);
            }
#pragma unroll
            for (int m = 0; m < 4; ++m) {
                const f32x4 g0a = acc[ai][0][m][0], g0b = acc[ai][0][m][1], va = acc[ai][1][m][0], vb = acc[ai][1][m][1];
                const f32x4 c1a = rot<0x121>(g0a), c1b = rot<0x121>(g0b), c2a = rot<0x122>(g0a), c2b = rot<0x122>(g0b);
                const f32x4 g1a = sel(fr >= 1, c1a, p1a), g1b = sel(fr >= 1, c1b, p1b), g2a = sel(fr >= 2, c2a, p2a), g2b = sel(fr >= 2, c2b, p2b);
                const f32x4 za = w0a * g2a + w1a * g1a + w2a * g0a + ba, zb = w0b * g2b + w1b * g1b + w2b * g0b + bb;
                const f32x4 oa = siluv(za) * va, ob = siluv(zb) * vb;
                const int rl = ai * 128 + wr * 64 + m * 16 + fr;
                if (grp == 0 && m == 0 && fr < 2 && !seq_start) {
                    float* fg = fixg + (size_t)(u.pm * 2 + fr) * DFF + ch; float* fv = fixv + (size_t)(u.pm * 2 + fr) * DFF + ch;
                    *(f32x4*)fg = g0a; *(f32x4*)(fg + 4) = g0b; *(f32x4*)fv = va; *(f32x4*)(fv + 4) = vb;
                } else {
                    u32x4 w; w.x = pk2(oa.x, oa.y); w.y = pk2(oa.z, oa.w); w.z = pk2(ob.x, ob.y); w.w = pk2(ob.z, ob.w);
                    *(u32x4*)(act + (size_t)(u.pm * 256 + rl) * DFF + ch) = w;
                }
                p1a = c1a; p1b = c1b; p2a = c2a; p2b = c2b;
                __builtin_amdgcn_sched_barrier(0);
            }
        }
        if (wr == 1 && fr >= 14) { float* tg = tailg + (size_t)(u.pm * 2 + (fr - 14)) * DFF + ch; *(f32x4*)tg = acc[1][0][3][0]; *(f32x4*)(tg + 4) = acc[1][0][3][1]; }
    }
};


__device__ __forceinline__ float xrow16_sum(float x) {
    auto s = __builtin_amdgcn_permlane16_swap(__float_as_uint(x), __float_as_uint(x), false, false);
    x = __uint_as_float(s[0]) + __uint_as_float(s[1]);
    auto t = __builtin_amdgcn_permlane32_swap(__float_as_uint(x), __float_as_uint(x), false, false);
    return __uint_as_float(t[0]) + __uint_as_float(t[1]);
}
template <bool FINAL> struct EpiNorm {
    static constexpr bool PERM = true, AFTER_DRAIN = false, MIDK = false;
    const float* base; float* outf; bf16* outb; const float* mod; const float* gain; float* slots; unsigned* cnt; LAS float* T; bf16* hb;
    __device__ __forceinline__ void operator()(f32x4 (&acc)[2][2][4][2], const pg8::Unit& u, int wr, int wc, int fr, int fq) const {
        asm volatile("" : "+v"(fr), "+v"(fq));
        const int wid = wr * 4 + wc, lane = fq * 16 + fr;
        const int b = (u.pm * 256) >> 11;
        const float* mrow = mod + b * 6144;
        constexpr int GOFF = FINAL ? 5120 : 2048;
        unsigned tw = (unsigned)(unsigned long)(T + (wr * 64 + fr) * 4 + wc), ts = (unsigned)(unsigned long)(T + 1024 + wr * 64 + fr);
        asm volatile("" : "+v"(tw), "+v"(ts));
        const int colb = u.pn * 256 + wc * 32 + 8 * fq;
        f32x4 Gv[2][2];
#pragma unroll
        for (int bj = 0; bj < 2; ++bj) { Gv[bj][0] = *(const f32x4*)(mrow + GOFF + colb + 128 * bj); Gv[bj][1] = *(const f32x4*)(mrow + GOFF + colb + 128 * bj + 4); }
        const size_t roff = ((size_t)u.pm * 256 + wr * 64 + fr) * DM + colb;
        const float* bp = base + roff;
        const bf16* hp = hb + roff;
        f32x4 Xv[2][2][2]; u32x4 Hq[2][2];
#pragma unroll
        for (int bj = 0; bj < 2; ++bj) {
            if constexpr (FINAL) Hq[0][bj] = *(const u32x4*)(hp + 128 * bj);
            else { Xv[0][bj][0] = *(const f32x4*)(bp + 128 * bj); Xv[0][bj][1] = *(const f32x4*)(bp + 128 * bj + 4); }
        }
#pragma unroll
        for (int it = 0; it < 8; ++it) {
            const int ai = it >> 2, m = it & 3;
            if (it + 1 < 8) { const size_t no = (size_t)(((it + 1) >> 2) * 128 + ((it + 1) & 3) * 16) * DM;
#pragma unroll
                for (int bj = 0; bj < 2; ++bj) {
                    if constexpr (FINAL) Hq[(it + 1) & 1][bj] = *(const u32x4*)(hp + no + 128 * bj);
                    else { Xv[(it + 1) & 1][bj][0] = *(const f32x4*)(bp + no + 128 * bj); Xv[(it + 1) & 1][bj][1] = *(const f32x4*)(bp + no + 128 * bj + 4); }
                } }
            const size_t row = (size_t)u.pm * 256 + ai * 128 + wr * 64 + m * 16 + fr;
            float ss = 0.f;
#pragma unroll
            for (int bj = 0; bj < 2; ++bj) {
                f32x4 x0, x1;
                if constexpr (FINAL) { const u32x4 q = Hq[it & 1][bj]; x0 = (f32x4){bflo(q.x), bfhi(q.x), bflo(q.y), bfhi(q.y)}; x1 = (f32x4){bflo(q.z), bfhi(q.z), bflo(q.w), bfhi(q.w)}; }
                else { x0 = Xv[it & 1][bj][0]; x1 = Xv[it & 1][bj][1]; }
                const f32x4 h0 = x0 + Gv[bj][0] * acc[ai][bj][m][0], h1 = x1 + Gv[bj][1] * acc[ai][bj][m][1];
                acc[ai][bj][m][0] = h0; acc[ai][bj][m][1] = h1;
                ss += (h0.x * h0.x + h0.y * h0.y) + (h0.z * h0.z + h0.w * h0.w) + (h1.x * h1.x + h1.y * h1.y) + (h1.z * h1.z + h1.w * h1.w);
                if constexpr (!FINAL) { u32x4 w; w.x = pk2(h0.x, h0.y); w.y = pk2(h0.z, h0.w); w.z = pk2(h1.x, h1.y); w.w = pk2(h1.z, h1.w); *(u32x4*)(hb + row * DM + colb + 128 * bj) = w; }
            }
            ss = xrow16_sum(ss);
            if (fq == 0) *(LAS float*)(unsigned long)(tw + (ai * 128 + m * 16) * 16) = ss;
            __builtin_amdgcn_sched_barrier(0);
        }
        asm volatile("s_waitcnt lgkmcnt(0)\n\ts_barrier" ::: "memory");
        const int r = wid * 32 + (lane & 31);
        if (lane < 32) {
            const f32x4 p = *(const LAS f32x4*)(T + r * 4);
            __hip_atomic_store(slots + ((size_t)u.pm * 256 + r) * 4 + u.pn, (p.x + p.y) + (p.z + p.w), __ATOMIC_RELAXED, __HIP_MEMORY_SCOPE_AGENT);
        }
        asm volatile("s_waitcnt vmcnt(0)" ::: "memory");
        unsigned* pc = cnt + 64 * u.pm;
        if (lane == 0) __hip_atomic_fetch_add(pc, 1u, __ATOMIC_RELAXED, __HIP_MEMORY_SCOPE_AGENT);
        if (wid == 0) {
            unsigned sp = 0;
            while ((unsigned)__builtin_amdgcn_readfirstlane((int)__hip_atomic_load(pc, __ATOMIC_RELAXED, __HIP_MEMORY_SCOPE_AGENT)) < 32u) { __builtin_amdgcn_s_sleep(2); if (++sp > (1u << 20)) break; }
            __builtin_amdgcn_fence(__ATOMIC_ACQUIRE, "agent");
        }
        asm volatile("s_waitcnt vmcnt(0) lgkmcnt(0)\n\ts_barrier" ::: "memory");
        if (lane < 32) {
            const float* sl = slots + ((size_t)u.pm * 256 + r) * 4;
            const float q = (__hip_atomic_load(sl, __ATOMIC_RELAXED, __HIP_MEMORY_SCOPE_AGENT) + __hip_atomic_load(sl + 1, __ATOMIC_RELAXED, __HIP_MEMORY_SCOPE_AGENT))
                          + (__hip_atomic_load(sl + 2, __ATOMIC_RELAXED, __HIP_MEMORY_SCOPE_AGENT) + __hip_atomic_load(sl + 3, __ATOMIC_RELAXED, __HIP_MEMORY_SCOPE_AGENT));
            T[1024 + r] = rsqrtf(q * (1.0f / DM) + 1e-6f);
        }
        asm volatile("s_waitcnt vmcnt(0) lgkmcnt(0)\n\ts_barrier" ::: "memory");
        f32x4 Nv[2][2], SCv[2][2], SHv[2][2];
#pragma unroll
        for (int bj = 0; bj < 2; ++bj) {
            Nv[bj][0] = *(const f32x4*)(gain + colb + 128 * bj); Nv[bj][1] = *(const f32x4*)(gain + colb + 128 * bj + 4);
            if constexpr (!FINAL) {
                SCv[bj][0] = *(const f32x4*)(mrow + 4096 + colb + 128 * bj) + 1.0f; SCv[bj][1] = *(const f32x4*)(mrow + 4096 + colb + 128 * bj + 4) + 1.0f;
                SHv[bj][0] = *(const f32x4*)(mrow + 3072 + colb + 128 * bj); SHv[bj][1] = *(const f32x4*)(mrow + 3072 + colb + 128 * bj + 4);
                Nv[bj][0] = Nv[bj][0] * SCv[bj][0]; Nv[bj][1] = Nv[bj][1] * SCv[bj][1];
            }
        }
#pragma unroll
        for (int ai = 0; ai < 2; ++ai)
#pragma unroll
            for (int m = 0; m < 4; ++m) {
                const int rl = ai * 128 + wr * 64 + m * 16 + fr; const size_t row = (size_t)u.pm * 256 + rl;
                const float rstd = *(const LAS float*)(unsigned long)(ts + (ai * 128 + m * 16) * 4);
#pragma unroll
                for (int bj = 0; bj < 2; ++bj) {
                    const int col = colb + 128 * bj;
                    f32x4 o0 = acc[ai][bj][m][0] * rstd * Nv[bj][0], o1 = acc[ai][bj][m][1] * rstd * Nv[bj][1];
                    if constexpr (FINAL) { *(f32x4*)(outf + row * DM + col) = o0; *(f32x4*)(outf + row * DM + col + 4) = o1; }
                    else {
                        o0 = o0 + SHv[bj][0]; o1 = o1 + SHv[bj][1];
                        u32x4 w; w.x = pk2(o0.x, o0.y); w.y = pk2(o0.z, o0.w); w.z = pk2(o1.x, o1.y); w.w = pk2(o1.z, o1.w);
                        *(u32x4*)(outb + row * DM + col) = w;
                    }
                }
                __builtin_amdgcn_sched_barrier(0);
            }
    }
};


struct EpiBranch {
    static constexpr bool PERM = true, AFTER_DRAIN = false, MIDK = true;
    bf16* out; const bf16* pg;
    __device__ __forceinline__ void mid(f32x4 (&acc)[2][2][4][2], const pg8::Unit& u, int wr, int wc, int fr, int fq) const {
        asm volatile("" : "+v"(fr), "+v"(fq));
        const bf16* gp = pg + ((size_t)u.pm * 256 + wr * 64 + fr) * 2048 + u.pn * 256 + wc * 32 + 8 * fq;
        u32x4 Gr[2][2];
#pragma unroll
        for (int bj = 0; bj < 2; ++bj) Gr[0][bj] = *(const u32x4*)(gp + 128 * bj);
#pragma unroll
        for (int it = 0; it < 8; ++it) {
            const int ai = it >> 2, m = it & 3;
            if (it + 1 < 8) { const bf16* np = gp + (size_t)(((it + 1) >> 2) * 128 + ((it + 1) & 3) * 16) * 2048;
#pragma unroll
                for (int bj = 0; bj < 2; ++bj) Gr[(it + 1) & 1][bj] = *(const u32x4*)(np + 128 * bj); }
#pragma unroll
            for (int bj = 0; bj < 2; ++bj) {
                const u32x4 gr = Gr[it & 1][bj];
                f32x4& v0 = acc[ai][bj][m][0]; f32x4& v1 = acc[ai][bj][m][1];
                v0[0] *= bflo(gr.x); v0[1] *= bfhi(gr.x); v0[2] *= bflo(gr.y); v0[3] *= bfhi(gr.y);
                v1[0] *= bflo(gr.z); v1[1] *= bfhi(gr.z); v1[2] *= bflo(gr.w); v1[3] *= bfhi(gr.w);
            }
            __builtin_amdgcn_sched_barrier(0);
        }
    }
    __device__ __forceinline__ void operator()(const f32x4 (&acc)[2][2][4][2], const pg8::Unit& u, int wr, int wc, int fr, int fq) const {
        asm volatile("" : "+v"(fr), "+v"(fq));
        const size_t row0 = (size_t)u.pm * 256 + wr * 64 + fr; const int colb = u.pn * 256 + wc * 32 + 8 * fq;
        const bf16* gp = pg + row0 * 2048 + 1024 + colb;
        u32x4 Gb[2][2];
#pragma unroll
        for (int bj = 0; bj < 2; ++bj) Gb[0][bj] = *(const u32x4*)(gp + 128 * bj);
#pragma unroll
        for (int it = 0; it < 8; ++it) {
            const int ai = it >> 2, m = it & 3;
            if (it + 1 < 8) { const bf16* np = gp + (size_t)(((it + 1) >> 2) * 128 + ((it + 1) & 3) * 16) * 2048;
#pragma unroll
                for (int bj = 0; bj < 2; ++bj) Gb[(it + 1) & 1][bj] = *(const u32x4*)(np + 128 * bj); }
            const size_t row = row0 + ai * 128 + m * 16;
#pragma unroll
            for (int bj = 0; bj < 2; ++bj) {
                const u32x4 gb = Gb[it & 1][bj];
                const f32x4 v0 = acc[ai][bj][m][0], v1 = acc[ai][bj][m][1];
                u32x4 w; w.x = pk2(v0[0] * bflo(gb.x), v0[1] * bfhi(gb.x)); w.y = pk2(v0[2] * bflo(gb.y), v0[3] * bfhi(gb.y));
                w.z = pk2(v1[0] * bflo(gb.z), v1[1] * bfhi(gb.z)); w.w = pk2(v1[2] * bflo(gb.w), v1[3] * bfhi(gb.w));
                *(u32x4*)(out + row * DM + colb + 128 * bj) = w;
            }
            __builtin_amdgcn_sched_barrier(0);
        }
    }
};


struct EpiProj {
    static constexpr bool PERM = true, AFTER_DRAIN = false, MIDK = false;
    Epi<EP_PROJ> base; bf16* la; float* fixl; float* taill; const float* mu; LAS float* X;
    static __device__ __forceinline__ f32x4 act4(f32x4 f, int cgrp) {
        const float k = cgrp == 0 ? 2.0f : 1.0f, sc = cgrp == 0 ? 2.0f : 1.0f, of = cgrp == 0 ? -1.0f : 0.0f;
        f32x4 y;
#pragma unroll
        for (int i = 0; i < 4; ++i) { const float sg = __builtin_amdgcn_rcpf(1.0f + __expf(-k * f[i])); const float v = fmaf(sc, sg, of); y[i] = cgrp == 1 ? f[i] : v; }
        return y;
    }
    __device__ __forceinline__ void operator()(const f32x4 (&acc)[2][2][4][2], const pg8::Unit& u, int wr, int wc, int fr, int fq) const {
        if (u.pn != 6) { base(acc, u, wr, wc, fr, fq); return; }
        asm volatile("" : "+v"(fr), "+v"(fq));
        if (fr == 15) {
#pragma unroll
            for (int ai = 0; ai < 2; ++ai)
#pragma unroll
                for (int bj = 0; bj < 2; ++bj) { LAS float* x = X + (ai * 2 + wr) * 256 + bj * 128 + wc * 32 + 8 * fq; *(LAS f32x4*)x = acc[ai][bj][3][0]; *(LAS f32x4*)(x + 4) = acc[ai][bj][3][1]; }
        }
        asm volatile("s_waitcnt lgkmcnt(0)\n\ts_barrier" ::: "memory");
        const bool seq_start = (u.pm & 7) == 0;
#pragma unroll
        for (int bj = 0; bj < 2; ++bj) {
            const int chl = bj * 128 + wc * 32 + 8 * fq, cgrp = chl >> 6;
            const f32x4 m0 = *(const f32x4*)(mu + 1536 + chl), m1 = *(const f32x4*)(mu + 1536 + chl + 4);
#pragma unroll
            for (int ai = 0; ai < 2; ++ai) {
                const int grp = ai * 2 + wr;
                f32x4 p1a = (f32x4){0.f, 0.f, 0.f, 0.f}, p1b = p1a;
                if (grp > 0) { const LAS float* x = X + (grp - 1) * 256 + chl; p1a = *(const LAS f32x4*)x; p1b = *(const LAS f32x4*)(x + 4); }
#pragma unroll
                for (int m = 0; m < 4; ++m) {
                    const f32x4 ca = acc[ai][bj][m][0], cb = acc[ai][bj][m][1];
                    const f32x4 c1a = EpiUp::rot<0x121>(ca), c1b = EpiUp::rot<0x121>(cb);
                    const f32x4 pa = EpiUp::sel(fr >= 1, c1a, p1a), pb = EpiUp::sel(fr >= 1, c1b, p1b);
                    const f32x4 fa = ca + (pa - ca) * m0, fb = cb + (pb - cb) * m1;
                    const int rl = ai * 128 + wr * 64 + m * 16 + fr;
                    if (grp == 0 && m == 0 && fr == 0 && !seq_start) {
                        float* fx = fixl + (size_t)u.pm * 256 + chl; *(f32x4*)fx = ca; *(f32x4*)(fx + 4) = cb;
                    } else {
                        const f32x4 ya = act4(fa, cgrp), yb = act4(fb, cgrp);
                        u32x4 w; w.x = pk2(ya.x, ya.y); w.y = pk2(ya.z, ya.w); w.z = pk2(yb.x, yb.y); w.w = pk2(yb.z, yb.w);
                        *(u32x4*)(la + ((size_t)u.pm * 256 + rl) * 256 + chl) = w;
                    }
                    p1a = c1a; p1b = c1b;
                    __builtin_amdgcn_sched_barrier(0);
                }
            }
            if (wr == 1 && fr == 15) { float* tx = taill + (size_t)u.pm * 256 + chl; *(f32x4*)tx = acc[1][bj][3][0]; *(f32x4*)(tx + 4) = acc[1][bj][3][1]; }
        }
    }
};

template <int REMAP_UP = 0> __device__ __forceinline__ void p0_transpose_item(const float* W, int K, int N, bf16* WT, LAS float* scr, int item, int lane, int ldo = 0, int koff = 0) {
    if (ldo == 0) ldo = K;
    const int nblk = N / 32, kb = item / nblk, nb = item % nblk, k0 = 64 * kb, n0 = 32 * nb;
    int r0 = n0;
    if constexpr (REMAP_UP == 1) r0 = n0 < DFF ? 256 * (n0 / 128) + (n0 % 128) : 256 * ((n0 - DFF) / 128) + 128 + ((n0 - DFF) % 128);
    if constexpr (REMAP_UP == 2) { if (n0 >= 2560) { const int j = n0 - 2560; r0 = j < 1024 ? 2560 + 256 * (j / 128) + (j % 128) : 2560 + 256 * ((j - 1024) / 128) + 128 + ((j - 1024) % 128); } }
    float wv[32];
#pragma unroll
    for (int i = 0; i < 32; ++i) { const int kk = 2 * i + (lane >> 5); wv[i] = W[(size_t)(k0 + kk) * N + n0 + (lane & 31)]; }
#pragma unroll
    for (int i = 0; i < 32; ++i) { const int kk = 2 * i + (lane >> 5); scr[kk * 33 + (lane & 31)] = wv[i]; }
    asm volatile("s_waitcnt lgkmcnt(0)" ::: "memory");
    const int c = lane & 7;
#pragma unroll
    for (int j = 0; j < 4; ++j) { const int n = (lane >> 3) + 8 * j; const LAS float* s = scr + (8 * c) * 33 + n;
        const float wsc = (REMAP_UP == 2 && n0 >= 2560) ? -1.4426950408889634f : 1.0f;
        u32x4 o; o.x = pk2(s[0 * 33] * wsc, s[1 * 33] * wsc); o.y = pk2(s[2 * 33] * wsc, s[3 * 33] * wsc); o.z = pk2(s[4 * 33] * wsc, s[5 * 33] * wsc); o.w = pk2(s[6 * 33] * wsc, s[7 * 33] * wsc);
        *(u32x4*)(WT + (size_t)(r0 + n) * ldo + koff + k0 + 8 * c) = o; }
    asm volatile("s_waitcnt lgkmcnt(0)" ::: "memory");
}


struct WcDesc { const float* src; bf16* dst; int N, ldo; float wsc; };
__device__ __forceinline__ WcDesc wc_decode(const float* W, int K, int N, bf16* WT, int item, int remap, int ldo, int koff) {
    if (ldo == 0) ldo = K;
    const int nblk = N / 32, kb = item / nblk, nb = item % nblk, k0 = 64 * kb, n0 = 32 * nb;
    int r0 = n0; float wsc = 1.0f;
    if (remap == 1) r0 = n0 < DFF ? 256 * (n0 / 128) + (n0 % 128) : 256 * ((n0 - DFF) / 128) + 128 + ((n0 - DFF) % 128);
    if (remap == 2 && n0 >= 2560) { const int j = n0 - 2560; r0 = j < 1024 ? 2560 + 256 * (j / 128) + (j % 128) : 2560 + 256 * ((j - 1024) / 128) + 128 + ((j - 1024) % 128); wsc = -1.4426950408889634f; }
    WcDesc d; d.src = W + (size_t)k0 * N + n0; d.dst = WT + (size_t)r0 * ldo + koff + k0; d.N = N; d.ldo = ldo; d.wsc = wsc; return d;
}
__device__ __forceinline__ void wc_load(const WcDesc& d, float (&wv)[32], int lane) {
#pragma unroll
    for (int i = 0; i < 32; ++i) { const int kk = 2 * i + (lane >> 5); wv[i] = d.src[(size_t)kk * d.N + (lane & 31)]; }
}
__device__ __forceinline__ void wc_store(const WcDesc& d, const float (&wv)[32], LAS float* scr, int lane) {
#pragma unroll
    for (int i = 0; i < 32; ++i) { const int kk = 2 * i + (lane >> 5); scr[kk * 33 + (lane & 31)] = wv[i]; }
    asm volatile("s_waitcnt lgkmcnt(0)" ::: "memory");
    const int c = lane & 7;
#pragma unroll
    for (int j = 0; j < 4; ++j) { const int n = (lane >> 3) + 8 * j; const LAS float* s = scr + (8 * c) * 33 + n; const float wsc = d.wsc;
        u32x4 o; o.x = pk2(s[0 * 33] * wsc, s[1 * 33] * wsc); o.y = pk2(s[2 * 33] * wsc, s[3 * 33] * wsc); o.z = pk2(s[4 * 33] * wsc, s[5 * 33] * wsc); o.w = pk2(s[6 * 33] * wsc, s[7 * 33] * wsc);
        *(u32x4*)(d.dst + (size_t)n * d.ldo + 8 * c) = o; }
    asm volatile("s_waitcnt lgkmcnt(0)" ::: "memory");
}

__device__ __forceinline__ void norm_mod_rows(const float* src, const float* gain, const float* mod, int shoff, int scoff, bf16* dst, int gw, int ngw, int lane) {
    constexpr int SPAN = 16;
    for (int m0 = gw * SPAN; m0 < M; m0 += ngw * SPAN) {
        const int b = m0 >> 11;
        f32x4 gs[4], sh[4];
#pragma unroll
        for (int j = 0; j < 4; ++j) {
            const f32x4 g = ((const f32x4*)gain)[64 * j + lane];
            const f32x4 sc = ((const f32x4*)(mod + b * 6144 + scoff))[64 * j + lane];
            sh[j] = ((const f32x4*)(mod + b * 6144 + shoff))[64 * j + lane];
            gs[j] = g * (sc + 1.0f);
        }
        f32x4 v[4], nv[4];
        { const f32x4* xr = (const f32x4*)(src + (size_t)m0 * DM) + lane;
#pragma unroll
          for (int j = 0; j < 4; ++j) v[j] = xr[64 * j]; }
#pragma unroll 1
        for (int i = 0; i < SPAN; ++i) {
            const int m = m0 + i;
            if (i + 1 < SPAN) { const f32x4* xr = (const f32x4*)(src + (size_t)(m + 1) * DM) + lane;
#pragma unroll
                for (int j = 0; j < 4; ++j) nv[j] = xr[64 * j]; }
            float s = 0.f;
#pragma unroll
            for (int j = 0; j < 4; ++j) s += (v[j].x * v[j].x + v[j].y * v[j].y) + (v[j].z * v[j].z + v[j].w * v[j].w);
            const float rstd = rsqrtf(wave_sum(s) * (1.f / DM) + 1e-6f);
            u32x2* o8 = (u32x2*)(dst + (size_t)m * DM) + lane;
#pragma unroll
            for (int j = 0; j < 4; ++j) {
                const f32x4 o = (v[j] * rstd) * gs[j] + sh[j];
                u32x2 w; w.x = pk2(o.x, o.y); w.y = pk2(o.z, o.w); o8[64 * j] = w;
            }
#pragma unroll
            for (int j = 0; j < 4; ++j) v[j] = nv[j];
        }
    }
}

constexpr int KPITCH = 72, VPITCH = 260;
__device__ __forceinline__ void attn_phase(LAS unsigned char* lds, const bf16* PQKV, bf16* Y2, const float* sinks, int bid, int G, int tid) {
    const int lane = tid & 63, wid = tid >> 6, r32 = lane & 31, hi = lane >> 5;
    LAS bf16* Kl = (LAS bf16*)lds;
    LAS bf16* Vt = (LAS bf16*)(lds + 256 * KPITCH * 2);
    for (int unit = bid; unit < NB * 16 * 2; unit += G) {
        const int kvh = unit & 1, blk = (unit >> 1) & 15, b = unit >> 5;
        __syncthreads();
        {
            const int key = tid >> 1, half = tid & 1;
            const int tpos = blk * 128 - 128 + key;
            u32x4 kv[4], vv[4];
            if (tpos >= 0) {
                const bf16* src = PQKV + (size_t)(b * SEQ + tpos) * ATTN_COLS + 512 + kvh * 64 + half * 32;
#pragma unroll
                for (int i = 0; i < 4; ++i) { kv[i] = *(const u32x4*)(src + 8 * i); vv[i] = *(const u32x4*)(src + 128 + 8 * i); }
            } else {
#pragma unroll
                for (int i = 0; i < 4; ++i) { kv[i] = (u32x4){0u, 0u, 0u, 0u}; vv[i] = (u32x4){0u, 0u, 0u, 0u}; }
            }
#pragma unroll
            for (int i = 0; i < 4; ++i) *(LAS u32x4*)(Kl + key * KPITCH + half * 32 + 8 * i) = kv[i];
#pragma unroll
            for (int i = 0; i < 4; ++i) {
                const int d0 = half * 32 + 8 * i;
                Vt[(d0 + 0) * VPITCH + key] = (bf16)(vv[i].x & 0xffffu); Vt[(d0 + 1) * VPITCH + key] = (bf16)(vv[i].x >> 16);
                Vt[(d0 + 2) * VPITCH + key] = (bf16)(vv[i].y & 0xffffu); Vt[(d0 + 3) * VPITCH + key] = (bf16)(vv[i].y >> 16);
                Vt[(d0 + 4) * VPITCH + key] = (bf16)(vv[i].z & 0xffffu); Vt[(d0 + 5) * VPITCH + key] = (bf16)(vv[i].z >> 16);
                Vt[(d0 + 6) * VPITCH + key] = (bf16)(vv[i].w & 0xffffu); Vt[(d0 + 7) * VPITCH + key] = (bf16)(vv[i].w >> 16);
            }
        }
        __syncthreads();
        for (int si = wid; si < 16; si += 8) {
            const int g = si >> 2, j = si & 3, head = kvh * 4 + g;
            const int tok = b * SEQ + blk * 128 + 32 * j + r32;
            bf16x8 qf[4];
#pragma unroll
            for (int d0 = 0; d0 < 4; ++d0) qf[d0] = *(const bf16x8*)(PQKV + (size_t)tok * ATTN_COLS + head * 64 + 16 * d0 + 8 * hi);
            f32x16 s[5];
#pragma unroll
            for (int kt = 0; kt < 5; ++kt) {
                s[kt] = (f32x16){0.f, 0.f, 0.f, 0.f, 0.f, 0.f, 0.f, 0.f, 0.f, 0.f, 0.f, 0.f, 0.f, 0.f, 0.f, 0.f};
#pragma unroll
                for (int d0 = 0; d0 < 4; ++d0) {
                    const bf16x8 kf = *(const LAS bf16x8*)(Kl + (32 * (j + kt) + r32) * KPITCH + 16 * d0 + 8 * hi);
                    s[kt] = __builtin_amdgcn_mfma_f32_32x32x16_bf16(kf, qf[d0], s[kt], 0, 0, 0);
                }
                __builtin_amdgcn_sched_barrier(0);
            }
            constexpr float L2E = 1.4426950408889634f;
            const float sl2 = exp2f(-(float)(head + 1)) * L2E, sink2 = sinks[head] * L2E;
            float mx = sink2;
            int dbase = r32 + 128 - 4 * hi; asm volatile("" : "+v"(dbase));
            const float bias = -sl2 * (float)dbase;
#pragma unroll
            for (int kt = 0; kt < 5; ++kt)
#pragma unroll
                for (int i = 0; i < 16; ++i) {
                    const int off = 32 * kt + (i & 3) + 8 * (i >> 2);
                    float v = fmaf(s[kt][i], 0.125f * L2E, fmaf(sl2, (float)off, bias));
                    bool valid = true;
                    if (kt == 0) valid = dbase - off < 128;
                    if (kt == 4) valid = dbase - off >= 0;
                    if (blk == 0 && j + kt < 4) valid = false;
                    v = valid ? v : -INFINITY;
                    s[kt][i] = v; mx = fmaxf(mx, v);
                }
            mx = fmaxf(mx, __shfl_xor(mx, 32));
            float sum = 0.f;
#pragma unroll
            for (int kt = 0; kt < 5; ++kt)
#pragma unroll
                for (int i = 0; i < 16; ++i) { const float p = __builtin_amdgcn_exp2f(s[kt][i] - mx); s[kt][i] = p; sum += p; }
            sum += __shfl_xor(sum, 32);
            const float inv = __builtin_amdgcn_rcpf(sum + __builtin_amdgcn_exp2f(sink2 - mx));
            f32x16 o[2];
            o[0] = (f32x16){0.f, 0.f, 0.f, 0.f, 0.f, 0.f, 0.f, 0.f, 0.f, 0.f, 0.f, 0.f, 0.f, 0.f, 0.f, 0.f}; o[1] = o[0];
#pragma unroll
            for (int kt = 0; kt < 5; ++kt)
#pragma unroll
                for (int st = 0; st < 2; ++st) {
                    u32x4 pw;
                    pw.x = pk2(s[kt][8 * st + 0] * inv, s[kt][8 * st + 1] * inv); pw.y = pk2(s[kt][8 * st + 2] * inv, s[kt][8 * st + 3] * inv);
                    pw.z = pk2(s[kt][8 * st + 4] * inv, s[kt][8 * st + 5] * inv); pw.w = pk2(s[kt][8 * st + 6] * inv, s[kt][8 * st + 7] * inv);
                    const bf16x8 pf = __builtin_bit_cast(bf16x8, pw);
#pragma unroll
                    for (int dt = 0; dt < 2; ++dt) {
                        const LAS bf16* vp = Vt + (32 * dt + r32) * VPITCH + 32 * (j + kt) + 16 * st + 4 * hi;
                        const u32x2 lo = *(const LAS u32x2*)vp, hh = *(const LAS u32x2*)(vp + 8);
                        const u32x4 vw = (u32x4){lo.x, lo.y, hh.x, hh.y};
                        o[dt] = __builtin_amdgcn_mfma_f32_32x32x16_bf16(__builtin_bit_cast(bf16x8, vw), pf, o[dt], 0, 0, 0);
                    }
                    __builtin_amdgcn_sched_barrier(0);
                }
            bf16* op = Y2 + (size_t)tok * DM + 512 + head * 64;
#pragma unroll
            for (int dt = 0; dt < 2; ++dt)
#pragma unroll
                for (int q4 = 0; q4 < 4; ++q4) {
                    u32x2 w; w.x = pk2(o[dt][4 * q4 + 0], o[dt][4 * q4 + 1]); w.y = pk2(o[dt][4 * q4 + 2], o[dt][4 * q4 + 3]);
                    *(u32x2*)(op + 32 * dt + 8 * q4 + 4 * hi) = w;
                }
        }
    }
}

constexpr int SC_T = 32, SC_STEP = 320, SC_VOFF = SC_T * SC_STEP, SC_BUF = SC_VOFF + 32 * SC_T;
struct ScanRegs { u32x2 r0, k0, v0, r1, k1, v1, as; f32x4 dec; };
__device__ __forceinline__ void scan_load(ScanRegs& R, const bf16* PR, const float* DEC, const bf16* ASIG, int b, int h, int t, int cg4) {
    const size_t row = (size_t)b * SEQ + t;
    const bf16* p = PR + row * RWKV_COLS + h * 64 + cg4;
    R.r0 = *(const u32x2*)p; R.k0 = *(const u32x2*)(p + 512); R.v0 = *(const u32x2*)(p + 1024);
    if (t > 0) { const bf16* q = p - RWKV_COLS; R.r1 = *(const u32x2*)q; R.k1 = *(const u32x2*)(q + 512); R.v1 = *(const u32x2*)(q + 1024); }
    else { R.r1 = (u32x2){0u, 0u}; R.k1 = R.r1; R.v1 = R.r1; }
    R.dec = *(const f32x4*)(DEC + row * RW + h * 64 + cg4);
    R.as = *(const u32x2*)(ASIG + row * RW + h * 64 + cg4);
}
__device__ __forceinline__ f32x4 unpack4(u32x2 w) { return (f32x4){bflo(w.x), bfhi(w.x), bflo(w.y), bfhi(w.y)}; }
__device__ __forceinline__ f32x4 lerp4(u32x2 cur, u32x2 prev, f32x4 mu) { const f32x4 c = unpack4(cur), p = unpack4(prev); return c + (p - c) * mu; }

__device__ __forceinline__ void scan_convert(const ScanRegs& R, LAS float* cbuf, int ls, int cg4, int half, size_t trow, int h, f32x4 mur, f32x4 muk, f32x4 muv, f32x4 kkw, f32x4 kaw, f32x4 rkw,
                                             float* BONP, bf16* FVP) {
    LAS float* d = cbuf + ls * SC_STEP + cg4;
    const f32x4 fr = lerp4(R.r0, R.r1, mur), fk = lerp4(R.k0, R.k1, muk), fv = lerp4(R.v0, R.v1, muv), as = unpack4(R.as);
    const f32x4 kr = fk * kkw;
    const float ss = sum16((kr.x * kr.x + kr.y * kr.y) + (kr.z * kr.z + kr.w * kr.w));
    const float inv = __builtin_amdgcn_rsqf(fmaxf(ss, 1e-24f));
    const f32x4 kk = kr * inv;
    *(LAS f32x4*)(d) = fr;
    *(LAS f32x4*)(d + 64) = R.dec;
    const f32x4 kp = fk * ((as - 1.0f) * kaw + 1.0f);
    *(LAS f32x4*)(d + 128) = kp;
    { const f32x4 q = fr * kp * rkw; const float bon = sum16((q.x + q.y) + (q.z + q.w));
      if (half == 0 && cg4 == 0) BONP[trow * 8 + h] = bon;
      if (half == 0) { u32x2 w; w.x = pk2(fv.x, fv.y); w.y = pk2(fv.z, fv.w); *(u32x2*)(FVP + trow * RW + h * 64 + cg4) = w; } }
    *(LAS f32x4*)(d + 192) = -kk;
    *(LAS f32x4*)(d + 256) = kk * as;
    if ((cg4 >> 5) == half) { LAS float* vb = cbuf + SC_VOFF + (cg4 & 31) * SC_T + ls; vb[0] = fv.x; vb[SC_T] = fv.y; vb[2 * SC_T] = fv.z; vb[3 * SC_T] = fv.w; }
}

__device__ __forceinline__ float rscatter16(const float (&p)[16], bool b3, bool b2, bool b1, bool b0) {
    float q[8], r[4], t[2];
#pragma unroll
    for (int i = 0; i < 8; ++i) { const float keep = b3 ? p[8 + i] : p[i], send = b3 ? p[i] : p[8 + i]; q[i] = keep + dppf<0x128>(send); }
#pragma unroll
    for (int i = 0; i < 4; ++i) { const float keep = b2 ? q[4 + i] : q[i], send = b2 ? q[i] : q[4 + i]; r[i] = keep + dppf<0x141>(send); }
#pragma unroll
    for (int i = 0; i < 2; ++i) { const float keep = b1 ? r[2 + i] : r[i], send = b1 ? r[i] : r[2 + i]; t[i] = keep + dppf<0x4E>(send); }
    const float keep = b0 ? t[1] : t[0], send = b0 ? t[0] : t[1];
    return keep + dppf<0xB1>(send);
}

__device__ __forceinline__ void scan_phase(LAS unsigned char* lds, const bf16* PR_, const float* DEC_, const bf16* ASIG_, bf16* Y,
                                           const float* mu, const float* k_k, const float* k_a, const float* r_k, float* BONP, bf16* FVP, int bid, int G, int tid) {
    LAS float* buf = (LAS float*)lds;
    const int lane = tid & 63, wid = tid >> 6;
    const bool loader = wid >= 4;
    const int ls = (tid & 255) >> 4, cg4 = (tid & 15) * 4;
    const int kg = lane & 15, rA = 4 * (wid & 3) + (lane >> 4), kg4 = kg * 4;
    for (int item = bid; item < NB * 16; item += G) {
        const int half = item & 1, h = (item >> 1) & 7, b = item >> 4;
        const int c0 = h * 64 + cg4;
        const f32x4 mur = *(const f32x4*)(mu + c0), muk = *(const f32x4*)(mu + 512 + c0), muv = *(const f32x4*)(mu + 1024 + c0);
        const f32x4 kkw = *(const f32x4*)(k_k + c0), kaw = *(const f32x4*)(k_a + c0), rkw = *(const f32x4*)(r_k + c0);
        bf16* yp = Y + ((size_t)b * SEQ + kg) * RW + h * 64 + half * 32 + rA;
        ScanRegs R0, R1, R2, R3;
        f32x2 SA01 = (f32x2){0.f, 0.f}, SA23 = SA01, SB01 = SA01, SB23 = SA01;
        if (loader) {
            scan_load(R0, PR_, DEC_, ASIG_, b, h, ls, cg4); scan_load(R1, PR_, DEC_, ASIG_, b, h, ls + 16, cg4);
            scan_load(R2, PR_, DEC_, ASIG_, b, h, SC_T + ls, cg4); scan_load(R3, PR_, DEC_, ASIG_, b, h, SC_T + ls + 16, cg4);
            const size_t trow = (size_t)b * SEQ + ls;
            scan_convert(R0, buf, ls, cg4, half, trow, h, mur, muk, muv, kkw, kaw, rkw, BONP, FVP);
            scan_convert(R1, buf, ls + 16, cg4, half, trow + 16, h, mur, muk, muv, kkw, kaw, rkw, BONP, FVP);
            scan_convert(R2, buf + SC_BUF, ls, cg4, half, trow + SC_T, h, mur, muk, muv, kkw, kaw, rkw, BONP, FVP);
            scan_convert(R3, buf + SC_BUF, ls + 16, cg4, half, trow + SC_T + 16, h, mur, muk, muv, kkw, kaw, rkw, BONP, FVP);
            scan_load(R0, PR_, DEC_, ASIG_, b, h, 2 * SC_T + ls, cg4); scan_load(R1, PR_, DEC_, ASIG_, b, h, 2 * SC_T + ls + 16, cg4);
        }
        __syncthreads();
#define SC_LDB(B_, R4, W4, K4, A4, B4, st) do { const LAS float* sb_ = (B_) + (st) * SC_STEP; R4 = *(const LAS f32x4*)(sb_ + kg4); W4 = *(const LAS f32x4*)(sb_ + 64 + kg4); \
    K4 = *(const LAS f32x4*)(sb_ + 128 + kg4); A4 = *(const LAS f32x4*)(sb_ + 192 + kg4); B4 = *(const LAS f32x4*)(sb_ + 256 + kg4); } while (0)
#define LO2(q) __builtin_shufflevector(q, q, 0, 1)
#define HI2(q) __builtin_shufflevector(q, q, 2, 3)
        f32x4 r4, w4, k4, a4, b4, nr, nw, nk, na, nb, vA4, nvA4, vB4, nvB4;
        float psaA = 0.f, psaB = 0.f;
        if (wid < 4) {
            SC_LDB(buf, r4, w4, k4, a4, b4, 0);
            SC_LDB(buf, nr, nw, nk, na, nb, 1);
            const LAS float* vr0 = buf + SC_VOFF + rA * SC_T;
            vA4 = *(const LAS f32x4*)vr0; nvA4 = *(const LAS f32x4*)(vr0 + 4); vB4 = *(const LAS f32x4*)(vr0 + 16 * SC_T); nvB4 = *(const LAS f32x4*)(vr0 + 16 * SC_T + 4);
            const f32x2 tA = SA01 * LO2(a4) + SA23 * HI2(a4), tB = SB01 * LO2(a4) + SB23 * HI2(a4); psaA = tA.x + tA.y; psaB = tB.x + tB.y;
        }
        int slot = 0;
        for (int c = 0; c < SEQ / SC_T; ++c) {
            const int slot1 = slot == 2 ? 0 : slot + 1, slot2 = slot1 == 2 ? 0 : slot1 + 1;
            if (loader && c + 2 < SEQ / SC_T) {
                LAS float* cbuf = buf + slot2 * SC_BUF;
                const size_t trow = (size_t)b * SEQ + (c + 2) * SC_T + ls;
                scan_convert(R0, cbuf, ls, cg4, half, trow, h, mur, muk, muv, kkw, kaw, rkw, BONP, FVP);
                scan_convert(R1, cbuf, ls + 16, cg4, half, trow + 16, h, mur, muk, muv, kkw, kaw, rkw, BONP, FVP);
                if (c + 3 < SEQ / SC_T) { scan_load(R0, PR_, DEC_, ASIG_, b, h, (c + 3) * SC_T + ls, cg4); scan_load(R1, PR_, DEC_, ASIG_, b, h, (c + 3) * SC_T + ls + 16, cg4); }
            }
            if (wid < 4) {
            const LAS float* cb = buf + slot * SC_BUF; const LAS float* nbuf = buf + slot1 * SC_BUF;
            const LAS float* vrA = cb + SC_VOFF + rA * SC_T; const LAS float* vrB = vrA + 16 * SC_T;
            const LAS float* nvrA = nbuf + SC_VOFF + rA * SC_T; const LAS float* nvrB = nvrA + 16 * SC_T;
            float PA[16], PB[16];
#pragma unroll
            for (int s = 0; s < SC_T; ++s) {
                f32x4 mr, mw, mk, ma, mb;
                if (s + 2 < SC_T) SC_LDB(cb, mr, mw, mk, ma, mb, s + 2); else SC_LDB(nbuf, mr, mw, mk, ma, mb, s + 2 - SC_T);
                const float vA = vA4[s & 3], vB = vB4[s & 3];
                const f32x2 mA01 = SA01 * LO2(w4) + LO2(k4) * vA, mA23 = SA23 * HI2(w4) + HI2(k4) * vA;
                const f32x2 mB01 = SB01 * LO2(w4) + LO2(k4) * vB, mB23 = SB23 * HI2(w4) + HI2(k4) * vB;
                psaA += dppf<0xB1>(psaA); psaB += dppf<0xB1>(psaB);
                psaA += dppf<0x4E>(psaA); psaB += dppf<0x4E>(psaB);
                psaA += dppf<0x141>(psaA); psaB += dppf<0x141>(psaB);
                psaA += dppf<0x128>(psaA); psaB += dppf<0x128>(psaB);
                SA01 = LO2(b4) * psaA + mA01; SA23 = HI2(b4) * psaA + mA23;
                SB01 = LO2(b4) * psaB + mB01; SB23 = HI2(b4) * psaB + mB23;
                { const f32x2 uA = SA01 * LO2(r4) + SA23 * HI2(r4), uB = SB01 * LO2(r4) + SB23 * HI2(r4); PA[s & 15] = uA.x + uA.y; PB[s & 15] = uB.x + uB.y; }
                if ((s & 15) == 15) {
                    const float yA = rscatter16(PA, (kg & 8) != 0, (kg & 4) != 0, (kg & 2) != 0, (kg & 1) != 0), yB = rscatter16(PB, (kg & 8) != 0, (kg & 4) != 0, (kg & 2) != 0, (kg & 1) != 0);
                    { const unsigned pw = pk2(yA, yB); yp[(size_t)(c * SC_T + (s - 15)) * RW] = (bf16)(pw & 0xffffu); yp[(size_t)(c * SC_T + (s - 15)) * RW + 16] = (bf16)(pw >> 16); }
                }
                { const f32x2 uA = SA01 * LO2(na) + SA23 * HI2(na), uB = SB01 * LO2(na) + SB23 * HI2(na); psaA = uA.x + uA.y; psaB = uB.x + uB.y; }
                r4 = nr; w4 = nw; k4 = nk; a4 = na; b4 = nb;
                nr = mr; nw = mw; nk = mk; na = ma; nb = mb;
                if ((s & 3) == 3) { vA4 = nvA4; vB4 = nvB4;
                    if (s + 5 < SC_T) { nvA4 = *(const LAS f32x4*)(vrA + s + 5); nvB4 = *(const LAS f32x4*)(vrB + s + 5); }
                    else { nvA4 = *(const LAS f32x4*)(nvrA + s + 5 - SC_T); nvB4 = *(const LAS f32x4*)(nvrB + s + 5 - SC_T); } }
            }
            }
            __syncthreads();
            slot = slot1;
        }
#undef SC_LDB
#undef LO2
#undef HI2
        __syncthreads();
    }
}

#define XB_TMO      128
#define XB_XCNT(j)  (256  + 64 * (j))
#define XB_XSUB(j)  (1280 + 64 * (j))
#define XB_XGEN(j)  (2304 + 64 * (j))
#define XB_TOP      3328
#define XB_TOPGEN   3392
#define XCD_BAR_WORDS 3456
#define XB_SPIN_CAP (1u << 18)

__device__ __forceinline__ unsigned xb_ld(unsigned* p)              { return __hip_atomic_load(p, __ATOMIC_RELAXED, __HIP_MEMORY_SCOPE_AGENT); }
__device__ __forceinline__ unsigned xb_add(unsigned* p, unsigned v) { return __hip_atomic_fetch_add(p, v, __ATOMIC_RELAXED, __HIP_MEMORY_SCOPE_AGENT); }
__device__ __forceinline__ unsigned xb_xcc_id() { return (unsigned)__builtin_amdgcn_s_getreg((3 << 11) | 20) & 0xFu; }
#define XB_SPIN(cond, bar) do { unsigned _sp = 0; while (cond) { __builtin_amdgcn_s_sleep(1); \
    if ((++_sp & 255u) == 0u) { if (xb_ld(&(bar)[XB_TMO])) break; if (_sp > XB_SPIN_CAP) { atomicAdd(&(bar)[XB_TMO], 1u); break; } } } } while (0)

struct XcdBarrier {
    unsigned* bar; unsigned x;
    volatile LAS unsigned* st;
};

__device__ __forceinline__ XcdBarrier xcd_barrier_post(unsigned* bar, volatile LAS unsigned* st) {
    XcdBarrier b; b.bar = bar; b.x = xb_xcc_id(); b.st = st;
    if (threadIdx.x == 0) (void)xb_add(&bar[XB_XCNT(b.x)], 1u);
    return b;
}
__device__ __forceinline__ void xcd_barrier_complete(unsigned* bar, unsigned x, unsigned& nloc, unsigned& nx) {
    const unsigned G = gridDim.x * gridDim.y * gridDim.z;
    unsigned sum, cnt, mine, sp = 0u;
    for (;;) {
        sum = 0u; cnt = 0u; mine = 0u;
#pragma unroll
        for (unsigned j = 0; j < 16; ++j) { const unsigned c = xb_ld(&bar[XB_XCNT(j)]); sum += c; cnt += (c > 0u) ? 1u : 0u; mine = (j == x) ? c : mine; }
        if (sum == G) break;
        __builtin_amdgcn_s_sleep(1);
        if ((++sp & 255u) == 0u) { if (xb_ld(&bar[XB_TMO])) break; if (sp > XB_SPIN_CAP) { atomicAdd(&bar[XB_TMO], 1u); break; } }
    }
    nloc = mine > 0u ? mine : 1u; nx = cnt > 0u ? cnt : 1u;
}

__device__ __forceinline__ void xcd_barrier(const XcdBarrier& b) {
    asm volatile("s_waitcnt vmcnt(0)" ::: "memory");
    __syncthreads();
    if (threadIdx.x == 0) {
        unsigned* bar = b.bar;
        __builtin_amdgcn_s_waitcnt(0);
        unsigned nloc = b.st[0], nx = b.st[1];
        if (nloc == 0u) { xcd_barrier_complete(bar, b.x, nloc, nx); b.st[0] = nloc; b.st[1] = nx; }
        const unsigned old = xb_add(&bar[XB_XSUB(b.x)], 1u);
        const unsigned gen = old / nloc;
        if (old + 1u == (gen + 1u) * nloc) {
            __builtin_amdgcn_fence(__ATOMIC_RELEASE, "agent");
            asm volatile("s_waitcnt vmcnt(0)" ::: "memory");
            const unsigned og = xb_add(&bar[XB_TOP], 1u);
            const unsigned tg = og / nx;
            if (og + 1u == (tg + 1u) * nx) xb_add(&bar[XB_TOPGEN], 1u);
            else XB_SPIN(xb_ld(&bar[XB_TOPGEN]) == tg, bar);
            __builtin_amdgcn_fence(__ATOMIC_ACQUIRE, "agent");
            xb_add(&bar[XB_XGEN(b.x)], 1u);
            asm volatile("s_waitcnt vmcnt(0)" ::: "memory");
        } else {
            XB_SPIN(xb_ld(&bar[XB_XGEN(b.x)]) == gen, bar);
            __builtin_amdgcn_fence(__ATOMIC_ACQUIRE, "agent");
            asm volatile("s_waitcnt vmcnt(0)" ::: "memory");
        }
    }
    __syncthreads();
}

struct Args { const float* in[27]; float* out; unsigned char* ws; int ph_lo, ph_hi; };
enum { I_X = 0, I_C, I_ADAW, I_ADAB, I_N1G, I_WIN, I_MU, I_W0, I_WUP, I_A0, I_AUP, I_GUP, I_KK, I_KA, I_RK, I_GNW, I_GNB, I_SINKS, I_WBA, I_WBB, I_WOUT, I_N2G,
       I_FUP, I_CONVW, I_CONVB, I_FDN, I_FING };
constexpr int LDS_BYTES = 147456;
constexpr int N_PHASES = 14;

__global__ void __launch_bounds__(NTHR, 2) fwd_kernel(Args a) {
    extern __shared__ __attribute__((aligned(16))) unsigned char lds_raw[];
    LAS unsigned char* lds = (LAS unsigned char*)lds_raw;
    cg::grid_group grid = cg::this_grid();
    volatile LAS unsigned* MISC = (volatile LAS unsigned*)(lds + 147456 - 64);
    if (threadIdx.x < 16) MISC[threadIdx.x] = 0u;
    __syncthreads();
    const XcdBarrier xbar = xcd_barrier_post((unsigned*)(a.ws + WS_CTL), MISC);
    const int G = gridDim.x, bid = blockIdx.x, NGW = G * NWAVES, GT = G * NTHR;
#define PHASE_IDS int tid = threadIdx.x; asm volatile("" : "+v"(tid)); const int lane = tid & 63, wave = __builtin_amdgcn_readfirstlane(tid >> 6); \
    const int gw = bid * NWAVES + wave, gtid = bid * NTHR + tid; (void)lane; (void)gw; (void)gtid;
typedef __attribute__((address_space(1))) unsigned char* GASP;
#define WSL unsigned long long wsl_ = (unsigned long long)a.ws; asm volatile("" : "+s"(wsl_)); const GASP wsl = (GASP)wsl_;
#define MOD ((float*)(__attribute__((address_space(1))) float*)(wsl + WS_MOD))
#define WIN_T ((bf16*)(__attribute__((address_space(1))) bf16*)(wsl + WS_WIN))
#define WLORA_T ((bf16*)(__attribute__((address_space(1))) bf16*)(wsl + WS_WLORA))
#define WA_T ((bf16*)(__attribute__((address_space(1))) bf16*)(wsl + WS_WA))
#define WB_T ((bf16*)(__attribute__((address_space(1))) bf16*)(wsl + WS_WB))
#define WOUT_T ((bf16*)(__attribute__((address_space(1))) bf16*)(wsl + WS_WOUT))
#define WUP_T ((bf16*)(__attribute__((address_space(1))) bf16*)(wsl + WS_WUP))
#define WDN_T ((bf16*)(__attribute__((address_space(1))) bf16*)(wsl + WS_WDN))
#define U ((bf16*)(__attribute__((address_space(1))) bf16*)(wsl + WS_U))
#define Y2 U
#define PG ((bf16*)(__attribute__((address_space(1))) bf16*)(wsl + WS_PG))
#define PR ((bf16*)(__attribute__((address_space(1))) bf16*)(wsl + WS_PR))
#define MERGED PR
#define PQKV ((bf16*)(__attribute__((address_space(1))) bf16*)(wsl + WS_PQKV))
#define GB ((bf16*)(__attribute__((address_space(1))) bf16*)(wsl + WS_G))
#define FIXL ((float*)(__attribute__((address_space(1))) float*)(wsl + WS_FIXL))
#define TAILL ((float*)(__attribute__((address_space(1))) float*)(wsl + WS_TAILL))
#define LA ((bf16*)(__attribute__((address_space(1))) bf16*)(wsl + WS_LA))
#define TMP ((bf16*)(__attribute__((address_space(1))) bf16*)(wsl + WS_TMP))
#define ASIG ((bf16*)(__attribute__((address_space(1))) bf16*)(wsl + WS_ASIG))
#define ACT ((bf16*)(__attribute__((address_space(1))) bf16*)(wsl + WS_ACT))
#define FIXG ((float*)(__attribute__((address_space(1))) float*)(wsl + WS_FIXG))
#define FIXV ((float*)(__attribute__((address_space(1))) float*)(wsl + WS_FIXV))
#define TAILG ((float*)(__attribute__((address_space(1))) float*)(wsl + WS_TAILG))
#define SLOT1 ((float*)(__attribute__((address_space(1))) float*)(wsl + WS_SLOT1))
#define SLOT2 ((float*)(__attribute__((address_space(1))) float*)(wsl + WS_SLOT2))
#define CNT1 ((unsigned*)(__attribute__((address_space(1))) unsigned*)(wsl + WS_CTL + 32768))
#define CNT2 ((unsigned*)(__attribute__((address_space(1))) unsigned*)(wsl + WS_CTL + 65536))
#define BON ((float*)(__attribute__((address_space(1))) float*)(wsl + WS_LA))
#define H1B ((bf16*)(__attribute__((address_space(1))) bf16*)(wsl + WS_H1B))
#define FV PQKV
#define DEC (a.out)
#define YS ((bf16*)(a.out + (size_t)M * RW))
    const int lo = a.ph_lo < 0 ? 0 : a.ph_lo, hi = a.ph_hi;
    const bool cg_seams = a.ph_lo < 0;
#ifndef ONLY
#define ONLY -1
#endif
#define IN(k) ((ONLY < 0 || ONLY == (k)) && lo <= (k) && (k) < hi)
#define SEAM(k) do { if (IN(k) && IN((k) + 1)) { if (cg_seams) grid.sync(); else xcd_barrier(xbar); } } while (0)

    if (IN(0)) { WSL
        PHASE_IDS
        LAS float* scr = (LAS float*)(lds + wave * 16384);
        constexpr int I_IN = 16 * 144, I_A = 8 * 32, I_O = 16 * 32, I_UP = 16 * 176, I_DN = 44 * 32;
        constexpr int NITEMS = I_IN + 2 * I_A + I_O + I_UP + I_DN;
#define WC_DECODE(it_, D_) do { int r = (it_); \
            if (r < I_IN) { D_ = wc_decode(a.in[I_WIN], 1024, IN_COLS, WIN_T, r, 2, 0, 0); break; } r -= I_IN; \
            if (r < I_A) { D_ = wc_decode(a.in[I_WBA], 512, 1024, WA_T, r, 0, 1024, 0); break; } r -= I_A; \
            if (r < I_A) { D_ = wc_decode(a.in[I_WBB], 512, 1024, WA_T, r, 0, 1024, 512); break; } r -= I_A; \
            if (r < I_O) { D_ = wc_decode(a.in[I_WOUT], 1024, 1024, WOUT_T, r, 0, 0, 0); break; } r -= I_O; \
            if (r < I_UP) { D_ = wc_decode(a.in[I_FUP], 1024, 2 * DFF, WUP_T, r, 1, 0, 0); break; } r -= I_UP; \
            D_ = wc_decode(a.in[I_FDN], DFF, 1024, WDN_T, r, 0, 0, 0); } while (0)
        if (gw < NITEMS) {
            WcDesc dc, dn; float wv[32], nv[32];
            WC_DECODE(gw, dc); wc_load(dc, wv, lane);
            for (int it = gw; it < NITEMS; it += NGW) {
                const bool more = it + NGW < NITEMS;
                if (more) { WC_DECODE(it + NGW, dn); wc_load(dn, nv, lane); }
                wc_store(dc, wv, scr, lane);
                if (more) { dc = dn;
#pragma unroll
                    for (int i = 0; i < 32; ++i) wv[i] = nv[i]; }
            }
        }
#undef WC_DECODE
        for (int idx = gtid; idx < 1536 * 256; idx += GT) {
            const int n = idx >> 8, k = idx & 255; float v = 0.f;
            if (n < 512) { if (k < 64) v = a.in[I_WUP][k * 512 + n]; }
            else if (n < 1024) { if (k >= 64 && k < 128) v = a.in[I_AUP][(k - 64) * 512 + (n - 512)]; }
            else { if (k >= 128) v = a.in[I_GUP][(k - 128) * 512 + (n - 1024)]; }
            WLORA_T[idx] = (bf16)(pk2(v, 0.f) & 0xffffu);
        }
        __syncthreads();
        if (bid < 96) {
            LAS float* cact = (LAS float*)lds;
            LAS float* part = (LAS float*)(lds + 65536);
            for (int i = tid; i < NB * DM; i += NTHR) { const int b = i >> 10, k = i & 1023; const float c = a.in[I_C][i]; cact[k * 16 + b] = c / (1.0f + __expf(-c)); }
            __syncthreads();
            const int col = 64 * bid + lane;
            float acc[16];
#pragma unroll
            for (int b = 0; b < 16; ++b) acc[b] = 0.f;
            for (int k = 128 * wave; k < 128 * wave + 128; ++k) {
                const float wv = a.in[I_ADAW][(size_t)k * 6144 + col];
                const LAS f32x4* cp = (const LAS f32x4*)(cact + k * 16);
#pragma unroll
                for (int q = 0; q < 4; ++q) { const f32x4 cv = cp[q]; acc[4 * q] += cv.x * wv; acc[4 * q + 1] += cv.y * wv; acc[4 * q + 2] += cv.z * wv; acc[4 * q + 3] += cv.w * wv; }
            }
#pragma unroll
            for (int b = 0; b < 16; ++b) part[(wave * 16 + b) * 64 + lane] = acc[b];
            __syncthreads();
            for (int i = tid; i < 16 * 64; i += NTHR) {
                const int b = i >> 6, l = i & 63; float s = a.in[I_ADAB][64 * bid + l];
#pragma unroll
                for (int w = 0; w < 8; ++w) s += part[(w * 16 + b) * 64 + l];
                MOD[b * 6144 + 64 * bid + l] = s;
            }
        }
    }
    SEAM(0);
    if (IN(1)) { WSL PHASE_IDS norm_mod_rows(a.in[I_X], a.in[I_N1G], MOD, 0, 1024, U, gw, NGW, lane); }
    SEAM(1);
    if (IN(2)) { WSL
        pg8::Gemm g{U, WIN_T, M, IN_COLS, DM, DM}; pg8::StaticOrder S; S.init(M, IN_COLS, G, bid);
        EpiProj E{Epi<EP_PROJ>{PR, PQKV, PG, nullptr, nullptr, nullptr, nullptr, nullptr}, LA, FIXL, TAILL, a.in[I_MU], (LAS float*)(lds + 131072)};
        pg8::gemm_phase<EpiProj, pg8::StaticOrder, true>(lds, g, S, E);
    }
    SEAM(2);
    if (IN(4)) { WSL PHASE_IDS
        pg8::Gemm g{LA, WLORA_T, M, 1536, 256, 256}; pg8::StaticOrder S; S.init(M, 1536, G, bid);
        {
            const float* mu = a.in[I_MU];
            pg8::Unit fu;
            for (int i = 0; S.next(i, fu); ++i) {
                const int pm = fu.pm;
                if ((pm & 7) == 0 || tid >= 64) continue;
                const int chl = 4 * tid;
                const f32x4 cur = *(const f32x4*)(FIXL + (size_t)pm * 256 + chl), prv = *(const f32x4*)(TAILL + (size_t)(pm - 1) * 256 + chl);
                const f32x4 f = cur + (prv - cur) * (*(const f32x4*)(mu + 1536 + chl));
                const f32x4 y = EpiProj::act4(f, chl >> 6);
                u32x2 w; w.x = pk2(y.x, y.y); w.y = pk2(y.z, y.w);
                *(u32x2*)(LA + (size_t)pm * 256 * 256 + chl) = w;
            }
            asm volatile("s_waitcnt vmcnt(0)" ::: "memory");
            __syncthreads();
        }
        Epi<EP_LORA> E{ASIG, GB, nullptr, DEC, a.in[I_W0], a.in[I_A0], nullptr, nullptr};
        pg8::gemm_phase<Epi<EP_LORA>, pg8::StaticOrder, true>(lds, g, S, E);
        attn_phase(lds, PQKV, Y2, a.in[I_SINKS], bid, G, tid);
    }
    SEAM(4);
    if (IN(5)) { WSL PHASE_IDS scan_phase(lds, PR, DEC, ASIG, YS, a.in[I_MU], a.in[I_KK], a.in[I_KA], a.in[I_RK], BON, FV, bid, G, tid); }
    SEAM(5);
    if (IN(6)) { WSL
        PHASE_IDS
        const float* mu = a.in[I_MU];
#pragma unroll 2
        for (int idx = gtid; idx < M * 128; idx += GT) {
            const int row = idx >> 7, h = (idx >> 4) & 7, c = h * 64 + (idx & 15) * 4;
            const f32x4 y4 = unpack4(*(const u32x2*)(YS + (size_t)row * RW + c));
            const float mean = sum16((y4.x + y4.y) + (y4.z + y4.w)) * (1.0f / 64.0f);
            const f32x4 d = y4 - mean;
            const float var = sum16((d.x * d.x + d.y * d.y) + (d.z * d.z + d.w * d.w)) * (1.0f / 64.0f);
            const float rs = rsqrtf(var + 64e-5f);
            const f32x4 yn = d * rs * (*(const f32x4*)(a.in[I_GNW] + c)) + (*(const f32x4*)(a.in[I_GNB] + c));
            const f32x4 fv = unpack4(*(const u32x2*)(FV + (size_t)row * RW + c));
            const float bonus = BON[(size_t)row * 8 + h];
            const f32x4 g = unpack4(*(const u32x2*)(GB + (size_t)row * RW + c));
            const f32x4 o = (yn + fv * bonus) * g;
            u32x2 w; w.x = pk2(o.x, o.y); w.y = pk2(o.z, o.w);
            *(u32x2*)(Y2 + (size_t)row * DM + c) = w;
        }
    }
    SEAM(6);
    if (IN(7)) { WSL
        pg8::Gemm g{Y2, WA_T, M, DM, DM, DM}; pg8::StaticOrder S; S.init(M, DM, G, bid);
        EpiBranch E{MERGED, PG};
        pg8::gemm_phase<EpiBranch, pg8::StaticOrder, true>(lds, g, S, E);
    }
    SEAM(7);
    if (IN(8)) { WSL
        pg8::Gemm g{MERGED, WOUT_T, M, DM, DM, DM}; pg8::StaticOrder S; S.init(M, DM, G, bid);
        EpiNorm<false> E{a.in[I_X], nullptr, U, MOD, a.in[I_N2G], SLOT1, CNT1, (LAS float*)(lds + 131072), H1B};
        pg8::gemm_phase<EpiNorm<false>, pg8::StaticOrder, true>(lds, g, S, E);
    }
    SEAM(8);
    if (IN(10)) { WSL
        pg8::Gemm g{U, WUP_T, M, 2 * DFF, DM, DM}; pg8::StaticOrder S; S.init(M, 2 * DFF, G, bid);
        EpiUp E{ACT, FIXG, FIXV, TAILG, a.in[I_CONVW], a.in[I_CONVB], (LAS float*)(lds + 131072)};
        pg8::gemm_phase<EpiUp, pg8::StaticOrder, true>(lds, g, S, E);
    }
    SEAM(10);
    if (IN(11)) { WSL
        PHASE_IDS
        const float* cw = a.in[I_CONVW]; const float* cb = a.in[I_CONVB];
        for (int idx = gtid; idx < 128 * 2 * (DFF / 4); idx += GT) {
            const int pm = idx / (2 * (DFF / 4)), rem = idx - pm * (2 * (DFF / 4)), rr = rem / (DFF / 4), ch = (rem - rr * (DFF / 4)) * 4;
            if ((pm & 7) == 0) continue;
            const f32x4 t0 = *(const f32x4*)(TAILG + (size_t)((pm - 1) * 2) * DFF + ch), t1 = *(const f32x4*)(TAILG + (size_t)((pm - 1) * 2 + 1) * DFF + ch);
            const f32x4 f0 = *(const f32x4*)(FIXG + (size_t)(pm * 2) * DFF + ch), f1 = *(const f32x4*)(FIXG + (size_t)(pm * 2 + 1) * DFF + ch);
            const f32x4 vv = *(const f32x4*)(FIXV + (size_t)(pm * 2 + rr) * DFF + ch);
            const f32x4 g2 = rr ? t1 : t0, g1 = rr ? f0 : t1, g0 = rr ? f1 : f0;
            const f32x4 z = (*(const f32x4*)(cw + ch)) * g2 + (*(const f32x4*)(cw + DFF + ch)) * g1 + (*(const f32x4*)(cw + 2 * DFF + ch)) * g0 + (*(const f32x4*)(cb + ch));
            const f32x4 o = EpiUp::siluv(z) * vv;
            u32x2 w; w.x = pk2(o.x, o.y); w.y = pk2(o.z, o.w);
            *(u32x2*)(ACT + (size_t)(pm * 256 + rr) * DFF + ch) = w;
        }
    }
    SEAM(11);
    if (IN(12)) { WSL
        pg8::Gemm g{ACT, WDN_T, M, DM, DFF, DFF}; pg8::StaticOrder S; S.init(M, DM, G, bid);
        EpiNorm<true> E{nullptr, a.out, nullptr, MOD, a.in[I_FING], SLOT2, CNT2, (LAS float*)(lds + 131072), H1B};
        pg8::gemm_phase<EpiNorm<true>, pg8::StaticOrder, true>(lds, g, S, E);
    }
#undef IN
#undef SEAM
}

extern "C" void kernel_launch(void* const* d_in, const int* in_sizes, int n_in, void* d_out, int out_size, void* d_ws, size_t ws_size, hipStream_t stream) {
    static int grid = 0;
    if (grid == 0) {
        if (n_in != 27 || out_size != M * DM || ws_size < WS_END) { fprintf(stderr, "kernel_launch: unexpected shapes: n_in %d out %d ws %zu (need %zu)\n", n_in, out_size, ws_size, (size_t)WS_END); grid = -1; return; }
        int dev = 0, cus = 0, per_cu = 0;
        (void)hipGetDevice(&dev);
        (void)hipDeviceGetAttribute(&cus, hipDeviceAttributeMultiprocessorCount, dev);
        if (hipFuncSetAttribute((const void*)fwd_kernel, hipFuncAttributeMaxDynamicSharedMemorySize, LDS_BYTES) != hipSuccess) { fprintf(stderr, "kernel_launch: hipFuncSetAttribute failed\n"); grid = -1; return; }
        if (hipOccupancyMaxActiveBlocksPerMultiprocessor(&per_cu, (const void*)fwd_kernel, NTHR, LDS_BYTES) != hipSuccess || per_cu < 1) { fprintf(stderr, "kernel_launch: occupancy query failed (%d)\n", per_cu); (void)hipGetLastError(); per_cu = 1; }
        grid = cus * per_cu; if (grid > 256) grid = 256;
        fprintf(stderr, "kernel_launch: cus %d per_cu %d grid %d\n", cus, per_cu, grid);
    }
    if (grid < 0) return;
    if (hipMemsetAsync((char*)d_ws + WS_CTL, 0, CTL_BYTES, stream) != hipSuccess) { fprintf(stderr, "kernel_launch: memset failed\n"); return; }
    Args a{};
    for (int i = 0; i < 27; ++i) a.in[i] = (const float*)d_in[i];
    a.out = (float*)d_out; a.ws = (unsigned char*)d_ws;
    a.ph_lo = 0; a.ph_hi = N_PHASES;
    void* args[] = {&a};
    hipError_t e = hipLaunchCooperativeKernel((const void*)fwd_kernel, dim3(grid), dim3(NTHR), args, LDS_BYTES, stream);
    if (e != hipSuccess) fprintf(stderr, "cooperative launch failed: %s (grid %d)\n", hipGetErrorString(e), grid);
}
```
